# Optimizing an MI355X kernel written in HIP

```python
import math
import jax
import jax.numpy as jnp
from jax import lax
import numpy as np

D_MODEL = 4096
BATCH = 1
SEQ = 16384
DEPTH = 2

GRID_W = 64
CTX_LEN = 256
D_MIX = D_MODEL
SSD_D_INNER = D_MIX // 2
SSD_HEAD_DIM = 64
SSD_HEADS = SSD_D_INNER // SSD_HEAD_DIM
SSD_GROUPS = 4
SSD_HPG = SSD_HEADS // SSD_GROUPS
SSD_STATE = 128
SSD_GN = SSD_GROUPS * SSD_STATE
SSD_XBC = SSD_D_INNER + 2 * SSD_GN
SSD_CONV = 5
SSD_CHUNK = 128
NA_WIDTH = D_MIX // 4
NA_HEAD_DIM = 128
NA_HEADS = NA_WIDTH // NA_HEAD_DIM
NA_WIN_R = 8
NA_WIN_C = 16
ROPE_BASE = 10000.0
POOL_WIDTH = D_MIX - SSD_D_INNER - NA_WIDTH
POOL_WINDOWS = (2, 4, 8, 16)
POOL_GROUP = POOL_WIDTH // len(POOL_WINDOWS)
D_FF = 11008
MLP_CONV = 3
N_MOD = 6
RMS_EPS = 1e-6
OFF_Z = 0
OFF_Q = OFF_Z + SSD_D_INNER
OFF_POOL = OFF_Q + NA_WIDTH
OFF_XBC = OFF_POOL + POOL_WIDTH
OFF_DT = OFF_XBC + SSD_XBC
OFF_K = OFF_DT + 2 * SSD_HEADS
OFF_V = OFF_K + NA_WIDTH
IN_COLS = OFF_V + NA_WIDTH

kernel_name = "hymba_style_ssd_natten_pool_dit"


def rmsnorm(x, w):
    xf = x.astype(jnp.float32)
    y = xf * lax.rsqrt(jnp.mean(xf * xf, axis=-1, keepdims=True) + RMS_EPS)
    return (y * w.astype(jnp.float32)).astype(x.dtype)


def modulate(x, shift, scale):
    return x * (1 + scale) + shift


def dwconv1d(x, w, b):
    K = w.shape[0]
    L = x.shape[1]
    left = (K - 1) // 2
    xp = jnp.pad(x, ((0, 0), (left, K - 1 - left), (0, 0)))
    y = b
    for k in range(K):
        y = y + xp[:, k:k + L] * w[k]
    return y


def axial_rope(L):
    t = jnp.arange(L)
    half = NA_HEAD_DIM // 2
    inv = ROPE_BASE ** (-jnp.arange(0, half, 2, dtype=jnp.float32) / half)
    ar = (t // GRID_W).astype(jnp.float32)[:, None] * inv
    ac = (t % GRID_W).astype(jnp.float32)[:, None] * inv
    ang = jnp.concatenate([ar, ar, ac, ac], axis=-1)[:, None, :]
    return jnp.cos(ang), jnp.sin(ang)


def _rotate_half(v):
    v1, v2 = jnp.split(v, 2, axis=-1)
    return jnp.concatenate([-v2, v1], axis=-1)


def apply_axial_rope(x, cos, sin):
    xf = x.astype(jnp.float32)
    half = x.shape[-1] // 2
    rot = jnp.concatenate([_rotate_half(xf[..., :half]), _rotate_half(xf[..., half:])], axis=-1)
    return (xf * cos + rot * sin).astype(x.dtype)


def _segsum(a):
    T = a.shape[-1]
    cs = jnp.cumsum(a, axis=-1)
    diff = cs[..., :, None] - cs[..., None, :]
    return jnp.where(jnp.tril(jnp.ones((T, T), dtype=bool)), diff, -jnp.inf)


def _chunks(a):
    b, L = a.shape[:2]
    return a.reshape((b, L // SSD_CHUNK, SSD_CHUNK) + a.shape[2:])


def _chunk_end_states(xc, a_cs, bc):
    decay = jnp.exp(a_cs[..., -1:] - a_cs)
    return jnp.einsum('bclgn,bgrcl,bclgrp->bcgrpn', bc, decay, xc)


def ssd_output(xdt, da, bm, cm, h0):
    xc, bc, cc = _chunks(xdt), _chunks(bm), _chunks(cm)
    ac = _chunks(da).transpose(0, 3, 4, 1, 2)
    a_cs = jnp.cumsum(ac, axis=-1)
    cb = jnp.einsum('bclgn,bcsgn->bgcls', cc, bc)
    y_diag = jnp.einsum('bgcls,bgrcls,bcsgrp->bclgrp', cb, jnp.exp(_segsum(ac)), xc)
    s_end = _chunk_end_states(xc[:, :-1], a_cs[..., :-1, :], bc[:, :-1])
    s_cat = jnp.concatenate([h0[:, None], s_end], axis=1)
    tot = a_cs[..., :-1, -1]
    decay_chunk = jnp.exp(_segsum(jnp.pad(tot, ((0, 0), (0, 0), (0, 0), (1, 0)))))
    h_in = jnp.einsum('bgrzc,bcgrpn->bzgrpn', decay_chunk, s_cat)
    y_off = jnp.einsum('bclgn,bcgrpn,bgrcl->bclgrp', cc, h_in, jnp.exp(a_cs))
    return (y_diag + y_off).reshape(xdt.shape)


def ssd_final_state(xdt, da, bm, h0):
    xc, bc = _chunks(xdt), _chunks(bm)
    a_cs = jnp.cumsum(_chunks(da).transpose(0, 3, 4, 1, 2), axis=-1)
    s_end = _chunk_end_states(xc, a_cs, bc)
    cum = jnp.cumsum(a_cs[..., -1], axis=-1)
    total = cum[..., -1:]
    return jnp.exp(total)[..., None] * h0 + jnp.einsum('bgrc,bcgrpn->bgrpn', jnp.exp(total - cum), s_end)


def _ssd_prep(xbc, dt_raw, conv_w, conv_b, dt_bias, a_log):
    b, L, _ = xbc.shape
    xbc = jax.nn.silu(dwconv1d(xbc, conv_w, conv_b)).astype(jnp.float32)
    xs = xbc[..., :SSD_D_INNER].reshape(b, L, SSD_GROUPS, SSD_HPG, SSD_HEAD_DIM)
    bm = xbc[..., SSD_D_INNER:SSD_D_INNER + SSD_GN].reshape(b, L, SSD_GROUPS, SSD_STATE)
    cm = xbc[..., SSD_D_INNER + SSD_GN:].reshape(b, L, SSD_GROUPS, SSD_STATE)
    dt = jax.nn.softplus(dt_raw.astype(jnp.float32).reshape(b, L, 2, SSD_HEADS) + dt_bias.astype(jnp.float32))
    da = dt * -jnp.exp(a_log.astype(jnp.float32))
    shape = (b, L, 2, SSD_GROUPS, SSD_HPG)
    return xs, bm, cm, dt.reshape(shape), da.reshape(shape)


def ssd_mixer(z_l, xbc_l, dt_l, z_c, xbc_c, dt_c, conv_w, conv_b, dt_bias, a_log, d_skip, norm_w):
    b, L, _ = xbc_l.shape
    xl, bl, cl, dtl, dal = _ssd_prep(xbc_l, dt_l, conv_w, conv_b, dt_bias, a_log)
    xc, bc, cc, dtc, dac = _ssd_prep(xbc_c, dt_c, conv_w, conv_b, dt_bias, a_log)
    d_sk = d_skip.astype(jnp.float32).reshape(SSD_GROUPS, SSD_HPG, 1)
    h_zero = jnp.zeros((b, SSD_GROUPS, SSD_HPG, SSD_HEAD_DIM, SSD_STATE), jnp.float32)
    y_l = xl * d_sk
    y_c = xc * d_sk if z_c is not None else None
    for direction in range(2):
        rev = (lambda a: a[:, ::-1]) if direction else (lambda a: a)
        xdt_c = rev(xc * dtc[:, :, direction, :, :, None])
        da_c = rev(dac[:, :, direction])
        b_c = rev(bc)
        h_ctx = ssd_final_state(xdt_c, da_c, b_c, h_zero)
        y_l = y_l + rev(ssd_output(rev(xl * dtl[:, :, direction, :, :, None]), rev(dal[:, :, direction]),
                                   rev(bl), rev(cl), h_ctx))
        if z_c is not None:
            y_c = y_c + rev(ssd_output(xdt_c, da_c, b_c, rev(cc), h_zero))
    out_l = rmsnorm(y_l.reshape(b, L, SSD_D_INNER) * jax.nn.silu(z_l.astype(jnp.float32)), norm_w).astype(z_l.dtype)
    out_c = None
    if z_c is not None:
        out_c = rmsnorm(y_c.reshape(b, -1, SSD_D_INNER) * jax.nn.silu(z_c.astype(jnp.float32)), norm_w).astype(z_c.dtype)
    return out_l, out_c


def neighbourhood_attention(q_l, k_l, v_l, q_c, k_c, v_c, q_norm_w, k_norm_w, rpb):
    b, L, _ = q_l.shape
    lc = k_c.shape[1]
    rows = L // GRID_W
    wr = min(NA_WIN_R, rows)
    hd = (NA_HEADS, NA_HEAD_DIM)
    scale = NA_HEAD_DIM ** -0.5
    cos, sin = axial_rope(L)
    q = apply_axial_rope(rmsnorm(q_l.reshape(b, L, *hd), q_norm_w), cos, sin)
    k = apply_axial_rope(rmsnorm(k_l.reshape(b, L, *hd), k_norm_w), cos, sin)
    v = v_l.reshape(b, L, *hd)
    kc = rmsnorm(k_c.reshape(b, lc, *hd), k_norm_w)
    vc = v_c.reshape(b, lc, *hd)
    r_idx = jnp.arange(rows)
    band = jnp.clip(r_idx - wr // 2, 0, rows - wr)[:, None] + jnp.arange(wr)[None, :]
    qg = q.reshape(b, rows, GRID_W, *hd)
    kg = k.reshape(b, rows, GRID_W, *hd)[:, band]
    vg = v.reshape(b, rows, GRID_W, *hd)[:, band]
    col = jnp.arange(GRID_W)
    c0 = jnp.clip(col - NA_WIN_C // 2, 0, GRID_W - NA_WIN_C)
    col_ok = (col[None, :] >= c0[:, None]) & (col[None, :] < c0[:, None] + NA_WIN_C)
    dr = band - r_idx[:, None] + (NA_WIN_R - 1)
    dc = jnp.clip(col[None, :] - col[:, None] + (NA_WIN_C - 1), 0, 2 * NA_WIN_C - 2)
    bias = rpb.astype(jnp.float32)[:, dr[:, None, :, None], dc[None, :, None, :]]
    s_loc = jnp.einsum('brqhd,brwkhd->bhrqwk', qg, kg).astype(jnp.float32) * scale + bias
    s_loc = jnp.where(col_ok[:, None, :], s_loc, -jnp.inf).reshape(b, NA_HEADS, rows, GRID_W, wr * GRID_W)
    s_ctx = jnp.einsum('brqhd,bjhd->bhrqj', qg, kc).astype(jnp.float32) * scale
    prob = jax.nn.softmax(jnp.concatenate([s_loc, s_ctx], axis=-1), axis=-1).astype(v.dtype)
    p_loc = prob[..., :wr * GRID_W].reshape(b, NA_HEADS, rows, GRID_W, wr, GRID_W)
    p_ctx = prob[..., wr * GRID_W:]
    o = jnp.einsum('bhrqwk,brwkhd->brqhd', p_loc, vg) + jnp.einsum('bhrqj,bjhd->brqhd', p_ctx, vc)
    y_l = o.reshape(b, L, NA_WIDTH)
    y_c = None
    if q_c is not None:
        qc = rmsnorm(q_c.reshape(b, lc, *hd), q_norm_w)
        s = jnp.einsum('bihd,bjhd->bhij', qc, kc).astype(jnp.float32) * scale
        pc = jax.nn.softmax(s, axis=-1).astype(vc.dtype)
        y_c = jnp.einsum('bhij,bjhd->bihd', pc, vc).reshape(b, lc, NA_WIDTH)
    return y_l, y_c


def multiscale_pool(u, pool_w, pool_scale):
    bsz, L, _ = u.shape
    uf = u.astype(jnp.float32)
    cs = jnp.pad(jnp.cumsum(uf, axis=1), ((0, 0), (1, 0), (0, 0)))
    t = jnp.arange(L)
    outs = []
    for g, w in enumerate(POOL_WINDOWS):
        lo = jnp.clip(t - w // 2, 0, L)
        hi = jnp.clip(t + w // 2, 0, L)
        seg = cs[..., g * POOL_GROUP:(g + 1) * POOL_GROUP]
        cnt = (hi - lo).astype(jnp.float32)[None, :, None]
        outs.append((seg[:, hi] - seg[:, lo]) / cnt - uf[..., g * POOL_GROUP:(g + 1) * POOL_GROUP])
    pooled = jnp.stack(outs, axis=2)
    y = jnp.einsum('blgc,gcd->blgd', pooled, pool_w.astype(jnp.float32)).reshape(bsz, L, POOL_WIDTH)
    return (y * pool_scale.astype(jnp.float32)).astype(u.dtype)


def conv_ffn(h, w_up, conv_w, conv_b, w_down):
    u = dwconv1d(h @ w_up, conv_w, conv_b)
    gate, val = jnp.split(u, 2, axis=-1)
    return (jax.nn.silu(gate) * val) @ w_down


def hybrid_layer(x, ctx, c, c_ctx, ada_w, ada_b, norm1_w, w_in, ssd_conv_w, ssd_conv_b, ssd_dt_bias,
                 ssd_a_log, ssd_d, ssd_norm_w, na_q_norm_w, na_k_norm_w, na_rpb, pool_w, pool_scale,
                 w_out, norm2_w, mlp_w_up, mlp_conv_w, mlp_conv_b, mlp_w_down, ctx_out):
    mod_l = (jax.nn.silu(c) @ ada_w + ada_b)[:, None, :]
    mod_c = jax.nn.silu(c_ctx) @ ada_w + ada_b
    sh1_l, sc1_l, g1_l, sh2_l, sc2_l, g2_l = jnp.split(mod_l, N_MOD, axis=-1)
    sh1_c, sc1_c, g1_c, sh2_c, sc2_c, g2_c = jnp.split(mod_c, N_MOD, axis=-1)
    h_l = modulate(rmsnorm(x, norm1_w), sh1_l, sc1_l)
    h_c = modulate(rmsnorm(ctx, norm1_w), sh1_c, sc1_c)
    p_l = h_l @ w_in
    base = 0 if ctx_out else OFF_XBC
    p_c = h_c @ w_in[:, base:]

    def seg_l(off, width):
        return p_l[..., off:off + width]

    def seg_c(off, width):
        return p_c[..., off - base:off - base + width]

    y_ssd_l, y_ssd_c = ssd_mixer(seg_l(OFF_Z, SSD_D_INNER), seg_l(OFF_XBC, SSD_XBC), seg_l(OFF_DT, 2 * SSD_HEADS),
                                 seg_c(OFF_Z, SSD_D_INNER) if ctx_out else None,
                                 seg_c(OFF_XBC, SSD_XBC), seg_c(OFF_DT, 2 * SSD_HEADS),
                                 ssd_conv_w, ssd_conv_b, ssd_dt_bias, ssd_a_log, ssd_d, ssd_norm_w)
    y_na_l, y_na_c = neighbourhood_attention(seg_l(OFF_Q, NA_WIDTH), seg_l(OFF_K, NA_WIDTH), seg_l(OFF_V, NA_WIDTH),
                                             seg_c(OFF_Q, NA_WIDTH) if ctx_out else None,
                                             seg_c(OFF_K, NA_WIDTH), seg_c(OFF_V, NA_WIDTH),
                                             na_q_norm_w, na_k_norm_w, na_rpb)
    y_pool_l = multiscale_pool(seg_l(OFF_POOL, POOL_WIDTH), pool_w, pool_scale)
    mix_l = jnp.concatenate([y_ssd_l, y_na_l, y_pool_l], axis=-1).astype(x.dtype) @ w_out
    x_new = x + g1_l * mix_l
    x_new = x_new + g2_l * conv_ffn(modulate(rmsnorm(x_new, norm2_w), sh2_l, sc2_l),
                                    mlp_w_up, mlp_conv_w, mlp_conv_b, mlp_w_down)
    ctx_new = ctx
    if ctx_out:
        y_pool_c = multiscale_pool(seg_c(OFF_POOL, POOL_WIDTH), pool_w, pool_scale)
        mix_c = jnp.concatenate([y_ssd_c, y_na_c, y_pool_c], axis=-1).astype(ctx.dtype) @ w_out
        ctx_new = ctx + g1_c * mix_c
        ctx_new = ctx_new + g2_c * conv_ffn(modulate(rmsnorm(ctx_new, norm2_w), sh2_c, sc2_c),
                                            mlp_w_up, mlp_conv_w, mlp_conv_b, mlp_w_down)
    return x_new, ctx_new


def setup_inputs(seed: int = 0) -> dict:
    key = jax.random.key(seed)
    ks = jax.random.split(key, 32)
    f32 = jnp.float32

    def nrm(k, shape, scale):
        return jax.random.normal(k, shape, f32) * scale

    dt0 = jnp.exp(jax.random.uniform(ks[10], (DEPTH, 2, SSD_HEADS), f32, math.log(1e-3), math.log(1e-1)))
    return {
        "x": nrm(ks[0], (BATCH, SEQ, D_MODEL), 1.0),
        "c": nrm(ks[1], (BATCH, D_MODEL), 1.0),
        "ctx": nrm(ks[2], (BATCH, CTX_LEN, D_MODEL), 1.0),
        "c_ctx": nrm(ks[3], (D_MODEL,), 1.0),
        "ada_w": nrm(ks[4], (DEPTH, D_MODEL, N_MOD * D_MODEL), 0.5 * D_MODEL ** -0.5),
        "ada_b": nrm(ks[5], (DEPTH, N_MOD * D_MODEL), 0.02),
        "norm1_w": 1.0 + nrm(ks[6], (DEPTH, D_MODEL), 0.02),
        "w_in": nrm(ks[7], (DEPTH, D_MODEL, IN_COLS), D_MODEL ** -0.5),
        "ssd_conv_w": nrm(ks[8], (DEPTH, SSD_CONV, SSD_XBC), SSD_CONV ** -0.5),
        "ssd_conv_b": nrm(ks[9], (DEPTH, SSD_XBC), 0.02),
        "ssd_dt_bias": dt0 + jnp.log(-jnp.expm1(-dt0)),
        "ssd_a_log": jnp.log(jax.random.uniform(ks[11], (DEPTH, 2, SSD_HEADS), f32, 1.0, 16.0)),
        "ssd_d": 1.0 + nrm(ks[12], (DEPTH, SSD_HEADS), 0.1),
        "ssd_norm_w": 1.0 + nrm(ks[13], (DEPTH, SSD_D_INNER), 0.02),
        "na_q_norm_w": 1.0 + nrm(ks[14], (DEPTH, NA_HEAD_DIM), 0.02),
        "na_k_norm_w": 1.0 + nrm(ks[15], (DEPTH, NA_HEAD_DIM), 0.02),
        "na_rpb": nrm(ks[16], (DEPTH, NA_HEADS, 2 * NA_WIN_R - 1, 2 * NA_WIN_C - 1), 0.1),
        "pool_w": nrm(ks[17], (DEPTH, len(POOL_WINDOWS), POOL_GROUP, POOL_GROUP), POOL_GROUP ** -0.5),
        "pool_scale": 1.0 + nrm(ks[18], (DEPTH, POOL_WIDTH), 0.1),
        "w_out": nrm(ks[19], (DEPTH, D_MIX, D_MODEL), D_MIX ** -0.5),
        "norm2_w": 1.0 + nrm(ks[20], (DEPTH, D_MODEL), 0.02),
        "mlp_w_up": nrm(ks[21], (DEPTH, D_MODEL, 2 * D_FF), D_MODEL ** -0.5),
        "mlp_conv_w": nrm(ks[22], (DEPTH, MLP_CONV, 2 * D_FF), MLP_CONV ** -0.5),
        "mlp_conv_b": nrm(ks[23], (DEPTH, 2 * D_FF), 0.02),
        "mlp_w_down": nrm(ks[24], (DEPTH, D_FF, D_MODEL), D_FF ** -0.5),
    }


def reference(x, c, ctx, c_ctx, ada_w, ada_b, norm1_w, w_in, ssd_conv_w, ssd_conv_b, ssd_dt_bias, ssd_a_log,
              ssd_d, ssd_norm_w, na_q_norm_w, na_k_norm_w, na_rpb, pool_w, pool_scale, w_out, norm2_w,
              mlp_w_up, mlp_conv_w, mlp_conv_b, mlp_w_down):
    for i in range(DEPTH):
        x, ctx = hybrid_layer(x, ctx, c, c_ctx, ada_w[i], ada_b[i], norm1_w[i], w_in[i], ssd_conv_w[i],
                              ssd_conv_b[i], ssd_dt_bias[i], ssd_a_log[i], ssd_d[i], ssd_norm_w[i],
                              na_q_norm_w[i], na_k_norm_w[i], na_rpb[i], pool_w[i], pool_scale[i], w_out[i],
                              norm2_w[i], mlp_w_up[i], mlp_conv_w[i], mlp_conv_b[i], mlp_w_down[i],
                              ctx_out=(i < DEPTH - 1))
    return x
```

```cpp
#include <hip/hip_runtime.h>
#include <cstdio>
#include <cstdint>

namespace pg8 {
#define PG8_LAS __attribute__((address_space(3)))
typedef unsigned short bf16_t;
typedef short bf16x8 __attribute__((ext_vector_type(8)));
typedef float f32x4 __attribute__((ext_vector_type(4)));
typedef unsigned u32x4 __attribute__((ext_vector_type(4)));
constexpr int BM = 256, BK = 64, HALF = 128, HTB = HALF * BK * 2, STAGE_BYTES = 8 * HTB, NXCD = 8, WGM = 4;

__host__ __device__ __forceinline__ int lds_byte(int r, int c) { const int st = (r >> 4) * 2 + (c >> 5), rr = r & 15, cc = c & 31, ob = rr * 64 + cc * 2; return st * 1024 + (ob ^ (((ob >> 9) & 1) << 5)); }
__host__ __device__ __forceinline__ void stage_rc(int b, int& R, int& C) { const int st = b / 1024, sb = b % 1024, swz = sb ^ (((sb >> 9) & 1) << 5); R = (st >> 1) * 16 + swz / 64; C = (st & 1) * 32 + (swz % 64) / 2; }
__host__ __device__ __forceinline__ int perm32(int rho) { const int n = rho >> 4, i = rho & 15; return 8 * (i >> 2) + 4 * n + (i & 3); }

struct Unit { int pm, pn; };
struct Gemm { const bf16_t* A; const bf16_t* Bt; int M, N, K, lda, ldb; };

struct StaticOrder {
    int nM, nN, nwg, G, c, pm0;
    __host__ __device__ void init(int M, int N, int G_, int c_, int pm0_ = 0) { nM = M / BM; nN = N / BM; nwg = nM * nN; G = G_; c = c_; pm0 = pm0_; }
    __host__ __device__ bool next(int i, Unit& u) const {
        const long L = (long)i * G + c; if (L >= nwg) return false;
        int wgid = (int)L; { const int q = nwg / NXCD, r = nwg % NXCD, xcd = wgid % NXCD, off = wgid / NXCD; wgid = (xcd < r ? xcd * (q + 1) : r * (q + 1) + (xcd - r) * q) + off; }
        const int nig = WGM * nN, gid = wgid / nig, fm = gid * WGM, gsz = (nM - fm) < WGM ? (nM - fm) : WGM;
        u.pm = pm0 + fm + ((wgid % nig) % gsz); u.pn = (wgid % nig) / gsz; return true;
    }
    __device__ __forceinline__ void a_ready(const Unit&) const {}
    __device__ __forceinline__ void done(const Unit&) const {}
};

__device__ __forceinline__ unsigned cvt_pk_bf16(float lo, float hi) { unsigned r; asm volatile("v_cvt_pk_bf16_f32 %0, %1, %2" : "=v"(r) : "v"(lo), "v"(hi)); return r; }

struct EpiBf16 {
    static constexpr bool PERM = true, AFTER_DRAIN = false;
    bf16_t* O; int ldc;
    __device__ __forceinline__ void operator()(const f32x4 (&acc)[2][2][4][2], const Unit& u, int wr, int wc, int fr, int fq) const {
        const int row0 = u.pm * BM + wr * 64 + fr; const int col0 = u.pn * BM + wc * 32 + 8 * fq;
#pragma unroll
        for (int ai = 0; ai < 2; ++ai)
#pragma unroll
            for (int m = 0; m < 4; ++m) { bf16_t* rowp = O + (size_t)(row0 + ai * HALF + m * 16) * ldc + col0;
#pragma unroll
                for (int bj = 0; bj < 2; ++bj) { const f32x4 v0 = acc[ai][bj][m][0], v1 = acc[ai][bj][m][1];
                    u32x4 w; w.x = cvt_pk_bf16(v0[0], v0[1]); w.y = cvt_pk_bf16(v0[2], v0[3]); w.z = cvt_pk_bf16(v1[0], v1[1]); w.w = cvt_pk_bf16(v1[2], v1[3]);
                    *(u32x4*)(rowp + bj * HALF) = w; } }
    }
};
template <bool BB, bool OB>
struct EpiResT {
    static constexpr bool PERM = true, AFTER_DRAIN = false;
    const void* base_l; void* out_l; const float* gate_l; int ldc;
    __device__ __forceinline__ void operator()(const f32x4 (&acc)[2][2][4][2], const Unit& u, int wr, int wc, int fr, int fq) const {
        const int row0 = (u.pm - 1) * BM + wr * 64 + fr, col0 = u.pn * BM + wc * 32 + 8 * fq;
        f32x4 gv[2][2];
#pragma unroll
        for (int bj = 0; bj < 2; ++bj)
#pragma unroll
            for (int n = 0; n < 2; ++n) gv[bj][n] = *(const f32x4*)(gate_l + col0 + bj * HALF + n * 4);
        constexpr int RD = BB ? 8 : 4;
        f32x4 bs[RD][BB ? 1 : 4]; u32x4 bh[RD][BB ? 2 : 1];
#define ERES_LOAD(buf, grp) do { const size_t off_ = (size_t)(row0 + ((grp) >> 2) * HALF + ((grp) & 3) * 16) * ldc + col0; \
            if constexpr (BB) { _Pragma("unroll") for (int bj = 0; bj < 2; ++bj) bh[buf][bj] = *(const u32x4*)((const bf16_t*)base_l + off_ + bj * HALF); } \
            else { _Pragma("unroll") for (int bj = 0; bj < 2; ++bj) _Pragma("unroll") for (int n = 0; n < 2; ++n) bs[buf][bj * 2 + n] = *(const f32x4*)((const float*)base_l + off_ + bj * HALF + n * 4); } } while (0)
#pragma unroll
        for (int g0 = 0; g0 < RD - 1; ++g0) ERES_LOAD(g0, g0);
#pragma unroll
        for (int grp = 0; grp < 8; ++grp) { const int ai = grp >> 2, m = grp & 3; const size_t off = (size_t)(row0 + ai * HALF + m * 16) * ldc + col0;
            if (grp + RD - 1 < 8) ERES_LOAD((grp + RD - 1) % RD, grp + RD - 1);
#pragma unroll
            for (int bj = 0; bj < 2; ++bj) {
                f32x4 r[2];
#pragma unroll
                for (int n = 0; n < 2; ++n) {
                    f32x4 b;
                    if constexpr (BB) { const unsigned w0 = bh[grp % RD][bj][2 * n], w1 = bh[grp % RD][bj][2 * n + 1];
                        b = (f32x4){__uint_as_float(w0 << 16), __uint_as_float(w0 & 0xffff0000u), __uint_as_float(w1 << 16), __uint_as_float(w1 & 0xffff0000u)}; }
                    else b = bs[grp % RD][bj * 2 + n];
                    r[n] = b + gv[bj][n] * acc[ai][bj][m][n]; }
                if constexpr (OB) { u32x4 w; w.x = cvt_pk_bf16(r[0][0], r[0][1]); w.y = cvt_pk_bf16(r[0][2], r[0][3]); w.z = cvt_pk_bf16(r[1][0], r[1][1]); w.w = cvt_pk_bf16(r[1][2], r[1][3]);
                    *(u32x4*)((bf16_t*)out_l + off + bj * HALF) = w; }
                else { *(f32x4*)((float*)out_l + off + bj * HALF) = r[0]; *(f32x4*)((float*)out_l + off + bj * HALF + 4) = r[1]; } }
            asm volatile("" ::: "memory"); }
#undef ERES_LOAD
    }
};
struct OneUnit {
    Unit u;
    __device__ __forceinline__ bool next(int i, Unit& o) const { if (i != 0) return false; o = u; return true; }
    __device__ __forceinline__ void a_ready(const Unit&) const {}
    __device__ __forceinline__ void done(const Unit&) const {}
};
struct EpiPart {
    static constexpr bool PERM = true, AFTER_DRAIN = false;
    float* C; int ldc;
    __device__ __forceinline__ void operator()(const f32x4 (&acc)[2][2][4][2], const Unit& u, int wr, int wc, int fr, int fq) const {
        const int row0 = wr * 64 + fr, col0 = u.pn * BM + wc * 32 + 8 * fq;
#pragma unroll
        for (int ai = 0; ai < 2; ++ai)
#pragma unroll
            for (int m = 0; m < 4; ++m) { float* rowp = C + (size_t)(row0 + ai * HALF + m * 16) * ldc + col0;
#pragma unroll
                for (int bj = 0; bj < 2; ++bj)
#pragma unroll
                    for (int n = 0; n < 2; ++n) *(f32x4*)(rowp + bj * HALF + n * 4) = acc[ai][bj][m][n]; }
    }
};
__device__ __forceinline__ float dpp_shr1(float edge, float v) { return __builtin_bit_cast(float, __builtin_amdgcn_update_dpp(__builtin_bit_cast(int, edge), __builtin_bit_cast(int, v), 0x111, 0xf, 0xf, false)); }
__device__ __forceinline__ float dpp_shl1(float edge, float v) { return __builtin_bit_cast(float, __builtin_amdgcn_update_dpp(__builtin_bit_cast(int, edge), __builtin_bit_cast(int, v), 0x101, 0xf, 0xf, false)); }
template <int N> __device__ __forceinline__ float dpp_ror(float v) { return __builtin_bit_cast(float, __builtin_amdgcn_mov_dpp(__builtin_bit_cast(int, v), 0x120 + N, 0xf, 0xf, true)); }
struct EpiFFN {
    static constexpr bool PERM = true, AFTER_DRAIN = false;
    bf16_t* ACT; const float* cw; const float* cb; bf16_t* E; int dff;
    __device__ __forceinline__ void operator()(const f32x4 (&acc)[2][2][4][2], const Unit& u, int wr, int wc, int fr, int fq) const {
        typedef unsigned u32x2 __attribute__((ext_vector_type(2)));
        u32x2 pend[2][4];
#pragma unroll
        for (int n = 0; n < 2; ++n) {
            const int ch = u.pn * HALF + wc * 32 + 8 * fq + 4 * n;
            const f32x4 g0 = *(const f32x4*)(cw + ch), g1 = *(const f32x4*)(cw + 2 * dff + ch), g2 = *(const f32x4*)(cw + 4 * dff + ch), gb = *(const f32x4*)(cb + ch);
            const f32x4 v0 = *(const f32x4*)(cw + dff + ch), v1 = *(const f32x4*)(cw + 3 * dff + ch), v2 = *(const f32x4*)(cw + 5 * dff + ch), vb = *(const f32x4*)(cb + dff + ch);
#pragma unroll
            for (int ai = 0; ai < 2; ++ai) {
                const int blk = 4 * u.pm + 2 * ai + wr;
#pragma unroll
                for (int m = 0; m < 4; ++m) {
                    const f32x4 gc = acc[ai][0][m][n], vc = acc[ai][1][m][n];
                    const f32x4 gpm = acc[ai][0][m > 0 ? m - 1 : 0][n], vpm = acc[ai][1][m > 0 ? m - 1 : 0][n];
                    const f32x4 gnm = acc[ai][0][m < 3 ? m + 1 : 3][n], vnm = acc[ai][1][m < 3 ? m + 1 : 3][n];
                    f32x4 gu, gd, vu, vd;
#pragma unroll
                    for (int e = 0; e < 4; ++e) {
                        gu[e] = dpp_shr1(dpp_ror<1>(gpm[e]), gc[e]); vu[e] = dpp_shr1(dpp_ror<1>(vpm[e]), vc[e]);
                        gd[e] = dpp_shl1(dpp_ror<15>(gnm[e]), gc[e]); vd[e] = dpp_shl1(dpp_ror<15>(vnm[e]), vc[e]); }
                    const f32x4 G = gb + g0 * gu + g1 * gc + g2 * gd, V = vb + v0 * vu + v1 * vc + v2 * vd;
                    const int rho = 16 * m + fr;
                    float o[4];
#pragma unroll
                    for (int e = 0; e < 4; ++e) o[e] = G[e] * __builtin_amdgcn_rcpf(1.f + __expf(-G[e])) * V[e];
                    u32x2 w; w.x = cvt_pk_bf16(o[0], o[1]); w.y = cvt_pk_bf16(o[2], o[3]);
                    if (n == 0) pend[ai][m] = w;
                    else if (rho != 0 && rho != 63) { u32x4 w4; w4.x = pend[ai][m].x; w4.y = pend[ai][m].y; w4.z = w.x; w4.w = w.y;
                        *(u32x4*)(ACT + (size_t)(u.pm * BM + ai * HALF + wr * 64 + rho) * dff + ch - 4) = w4; }
                    if ((m == 0 && fr < 2) || (m == 3 && fr >= 14)) {
                        const int slot = (m == 0) ? fr : fr - 12;
                        bf16_t* ep = E + ((size_t)(blk * 4 + slot) * 2 * dff) + u.pn * BM + wc * 32 + 8 * fq + 4 * n;
                        u32x2 eg, ev; eg.x = cvt_pk_bf16(gc[0], gc[1]); eg.y = cvt_pk_bf16(gc[2], gc[3]); ev.x = cvt_pk_bf16(vc[0], vc[1]); ev.y = cvt_pk_bf16(vc[2], vc[3]);
                        *(u32x2*)ep = eg; *(u32x2*)(ep + HALF) = ev;
                    }
                }
            }
        }
    }
};

template <class Epi, class Sched, bool ALIGN_EPI = false, bool SP2 = false>
__device__ __forceinline__ void gemm_phase(PG8_LAS unsigned char* lds, const Gemm g, const Sched& S, const Epi& E, int tid) {
    asm volatile("" : "+v"(tid));
    const int wid = __builtin_amdgcn_readfirstlane(tid >> 6), lane = tid & 63, wr = wid >> 2, wc = wid & 3, fr = lane & 15, fq = lane >> 4;
    const int K = g.K, nt = K / BK;
    unsigned voffA[2], voffB[2];
#pragma unroll
    for (int i = 0; i < 2; ++i) { int R, C; stage_rc(tid * 16 + i * 8192, R, C); const int Rb = Epi::PERM ? ((R & ~31) + perm32(R & 31)) : R;
        voffA[i] = (unsigned)(R * g.lda + C) * 2u; voffB[i] = (unsigned)(Rb * g.ldb + C) * 2u; }
    const size_t kstep = (size_t)(BK * 2);
    const size_t hstepA = (size_t)HALF * g.lda * 2, hstepB = (size_t)HALF * g.ldb * 2;
    const size_t tstepA = 2 * hstepA, tstepB = 2 * hstepB;
    const unsigned ldsw = (unsigned)wid * 1024u;
    const int aoff = lds_byte(wr * 64 + fr, fq * 8), boff = lds_byte(wc * 32 + fr, fq * 8);
#define PG8_SA(b, h) (((b) * 2 + (h)) * HTB)
#define PG8_SB(b, h) ((4 + (b) * 2 + (h)) * HTB)
#define PG8_STAGE(bufoff, gbase, voff) do { _Pragma("unroll") for (int _i = 0; _i < 2; ++_i) \
        __builtin_amdgcn_global_load_lds((const unsigned*)((const char*)(gbase) + (voff)[_i]), (PG8_LAS unsigned*)(lds + (bufoff) + ldsw + _i * 8192), 16, 0, 0); } while (0)
#define PG8_LDA(dst, b, h) do { _Pragma("unroll") for (int m = 0; m < 4; ++m) _Pragma("unroll") for (int k = 0; k < 2; ++k) dst[m][k] = *(const PG8_LAS bf16x8*)(lds + PG8_SA(b, h) + aoff + m * 2048 + k * 1024); } while (0)
#define PG8_LDB(dst, b, h) do { _Pragma("unroll") for (int n = 0; n < 2; ++n) _Pragma("unroll") for (int k = 0; k < 2; ++k) dst[n][k] = *(const PG8_LAS bf16x8*)(lds + PG8_SB(b, h) + boff + n * 2048 + k * 1024); } while (0)
#define PG8_MMA(ai, bj, At, Bt) do { __builtin_amdgcn_s_setprio(1); _Pragma("unroll") for (int m = 0; m < 4; ++m) _Pragma("unroll") for (int n = 0; n < 2; ++n) _Pragma("unroll") for (int k = 0; k < 2; ++k) \
        acc[ai][bj][m][n] = __builtin_amdgcn_mfma_f32_16x16x32_bf16(Bt[n][k], At[m][k], acc[ai][bj][m][n], 0, 0, 0); __builtin_amdgcn_s_setprio(0); } while (0)
#define PG8_WAIT_V(n) asm volatile("s_waitcnt vmcnt(" #n ")" ::: "memory")
#define PG8_WAIT_L(n) asm volatile("s_waitcnt lgkmcnt(" #n ")" ::: "memory")
#define PG8_BAR __builtin_amdgcn_s_barrier()
#define PG8_SCHED __builtin_amdgcn_sched_barrier(0)
    Unit cur, nxt; int ui = 0;
    if (!S.next(0, cur)) return;
    f32x4 acc[2][2][4][2];
#pragma unroll
    for (int a = 0; a < 2; ++a)
#pragma unroll
        for (int b = 0; b < 2; ++b)
#pragma unroll
            for (int m = 0; m < 4; ++m)
#pragma unroll
                for (int n = 0; n < 2; ++n) acc[a][b][m][n] = (f32x4){0.f, 0.f, 0.f, 0.f};
    bf16x8 At[4][2], B0[2][2], B1[2][2];
    const char* cA = (const char*)g.A + (size_t)cur.pm * tstepA; const char* cB = (const char*)g.Bt + (size_t)cur.pn * tstepB;
    S.a_ready(cur);
    if constexpr (SP2) {
        PG8_STAGE(PG8_SB(0, 0), cB, voffB); PG8_STAGE(PG8_SB(0, 1), cB + hstepB, voffB); PG8_STAGE(PG8_SA(0, 0), cA, voffA); PG8_STAGE(PG8_SA(0, 1), cA + hstepA, voffA);
        if (wr == 1) PG8_BAR;
        PG8_WAIT_V(2); PG8_BAR;
        PG8_STAGE(PG8_SB(1, 0), cB + kstep, voffB); PG8_STAGE(PG8_SA(1, 0), cA + kstep, voffA); PG8_STAGE(PG8_SB(1, 1), cB + hstepB + kstep, voffB);
        PG8_WAIT_V(6); PG8_BAR;
    } else {
        PG8_STAGE(PG8_SB(0, 0), cB, voffB); PG8_STAGE(PG8_SA(0, 0), cA, voffA); PG8_STAGE(PG8_SB(0, 1), cB + hstepB, voffB); PG8_STAGE(PG8_SA(0, 1), cA + hstepA, voffA);
        if (wr == 1) PG8_BAR;
        PG8_WAIT_V(4); PG8_BAR;
        PG8_STAGE(PG8_SB(1, 0), cB + kstep, voffB); PG8_STAGE(PG8_SA(1, 0), cA + kstep, voffA); PG8_STAGE(PG8_SB(1, 1), cB + hstepB + kstep, voffB);
        PG8_WAIT_V(6); PG8_BAR;
    }
    for (;;) {
        const bool has_next = S.next(ui + 1, nxt);
        const char* nA = has_next ? (const char*)g.A + (size_t)nxt.pm * tstepA : cA; const char* nB = has_next ? (const char*)g.Bt + (size_t)nxt.pn * tstepB : cB;
        for (int t = 0; t < nt; t += 2) {
            const bool last = (t == nt - 2);
            const char* a1 = cA + (size_t)(t + 1) * kstep;
            const char* a2 = last ? nA : cA + (size_t)(t + 2) * kstep; const char* b2 = last ? nB : cB + (size_t)(t + 2) * kstep;
            const char* a3 = a2 + kstep; const char* b3 = b2 + kstep;
            if (last && has_next) S.a_ready(nxt);
            if constexpr (SP2) {
            PG8_LDB(B0, 0, 0); PG8_LDB(B1, 0, 1); PG8_SCHED; PG8_LDA(At, 0, 0); PG8_STAGE(PG8_SA(1, 1), a1 + hstepA, voffA);
            PG8_WAIT_V(8); PG8_WAIT_L(0); PG8_BAR; PG8_MMA(0, 0, At, B0); PG8_MMA(0, 1, At, B1); PG8_BAR; PG8_SCHED;
            PG8_LDA(At, 0, 1); PG8_STAGE(PG8_SB(0, 0), b2, voffB); PG8_STAGE(PG8_SB(0, 1), b2 + hstepB, voffB); PG8_STAGE(PG8_SA(0, 0), a2, voffA);
            PG8_WAIT_V(8); PG8_WAIT_L(0); PG8_BAR; PG8_MMA(1, 0, At, B0); PG8_MMA(1, 1, At, B1); PG8_BAR; PG8_SCHED;
            PG8_LDB(B0, 1, 0); PG8_LDB(B1, 1, 1); PG8_SCHED; PG8_LDA(At, 1, 0); PG8_STAGE(PG8_SA(0, 1), a2 + hstepA, voffA);
            PG8_WAIT_V(8); PG8_WAIT_L(0); PG8_BAR; PG8_MMA(0, 0, At, B0); PG8_MMA(0, 1, At, B1); PG8_BAR; PG8_SCHED;
            PG8_LDA(At, 1, 1); PG8_STAGE(PG8_SB(1, 0), b3, voffB); PG8_STAGE(PG8_SB(1, 1), b3 + hstepB, voffB); PG8_STAGE(PG8_SA(1, 0), a3, voffA);
            PG8_WAIT_V(8); PG8_WAIT_L(0); PG8_BAR; PG8_MMA(1, 0, At, B0); PG8_MMA(1, 1, At, B1); PG8_BAR; PG8_SCHED;
            } else {
            PG8_LDB(B0, 0, 0); PG8_SCHED; PG8_LDA(At, 0, 0); PG8_STAGE(PG8_SA(1, 1), a1 + hstepA, voffA);
            PG8_WAIT_L(8); PG8_BAR; PG8_WAIT_L(0); PG8_MMA(0, 0, At, B0); PG8_BAR; PG8_SCHED;
            PG8_LDB(B1, 0, 1); PG8_STAGE(PG8_SB(0, 0), b2, voffB);
            PG8_BAR; PG8_WAIT_L(0); PG8_MMA(0, 1, At, B1); PG8_BAR;
            PG8_LDA(At, 0, 1); PG8_STAGE(PG8_SA(0, 0), a2, voffA);
            PG8_BAR; PG8_WAIT_L(0); PG8_MMA(1, 0, At, B0); PG8_BAR; PG8_SCHED;
            PG8_STAGE(PG8_SB(0, 1), b2 + hstepB, voffB);
            PG8_WAIT_V(6); PG8_BAR; PG8_MMA(1, 1, At, B1); PG8_BAR;
            PG8_LDB(B0, 1, 0); PG8_SCHED; PG8_LDA(At, 1, 0); PG8_STAGE(PG8_SA(0, 1), a2 + hstepA, voffA);
            PG8_WAIT_L(8); PG8_BAR; PG8_WAIT_L(0); PG8_MMA(0, 0, At, B0); PG8_BAR; PG8_SCHED;
            PG8_LDB(B1, 1, 1); PG8_STAGE(PG8_SB(1, 0), b3, voffB);
            PG8_BAR; PG8_WAIT_L(0); PG8_MMA(0, 1, At, B1); PG8_BAR;
            PG8_LDA(At, 1, 1); PG8_STAGE(PG8_SA(1, 0), a3, voffA);
            PG8_BAR; PG8_WAIT_L(0); PG8_MMA(1, 0, At, B0); PG8_BAR; PG8_SCHED;
            PG8_STAGE(PG8_SB(1, 1), b3 + hstepB, voffB);
            PG8_WAIT_V(6); PG8_BAR; PG8_MMA(1, 1, At, B1); PG8_BAR;
            }
        }
        if constexpr (ALIGN_EPI) { if (wr == 0) PG8_BAR; }
        if constexpr (!Epi::AFTER_DRAIN) { E(acc, cur, wr, wc, fr, fq); S.done(cur); }
        if (!has_next) break;
#pragma unroll
        for (int a = 0; a < 2; ++a)
#pragma unroll
            for (int b = 0; b < 2; ++b)
#pragma unroll
                for (int m = 0; m < 4; ++m)
#pragma unroll
                    for (int n = 0; n < 2; ++n) acc[a][b][m][n] = (f32x4){0.f, 0.f, 0.f, 0.f};
        cur = nxt; cA = nA; cB = nB; ++ui;
        if constexpr (ALIGN_EPI) { if (wr == 1) PG8_BAR; }
    }
    PG8_WAIT_V(0);
    if constexpr (!ALIGN_EPI) { if (wr == 0) PG8_BAR; }
    PG8_BAR;
#undef PG8_SA
#undef PG8_SB
#undef PG8_STAGE
#undef PG8_LDA
#undef PG8_LDB
#undef PG8_MMA
#undef PG8_WAIT_V
#undef PG8_WAIT_L
#undef PG8_BAR
#undef PG8_SCHED
}
}

constexpr int NWAVES = 8;
#ifndef MK_ONE_LAUNCH
#define MK_ONE_LAUNCH 1
#endif

#ifndef PROBE_DUP
#define PROBE_DUP -1
#endif
#define NREP(k) ((PROBE_DUP) == (k) ? 2 : 1)
constexpr int D = 4096, SEQ = 16384, CTX = 256, R = SEQ + CTX;
constexpr int DEPTH = 2;
constexpr int IN_COLS = 9280, NIN = 9472;
constexpr int OFF_Z = 0, OFF_Q = 2048, OFF_POOL = 3072, OFF_XBC = 4096, OFF_DT = 7168, OFF_K = 7232, OFF_V = 8256;
constexpr int SSD_DI = 2048, SSD_XBC = 3072, SSD_GN = 512;
constexpr int DFF = 11008, DFF2 = 22016;
constexpr int GRID_W = 64;
constexpr float RMS_EPS = 1e-6f;
constexpr int NMOD = 6 * D;
constexpr int NCHUNK = R / 128;

constexpr size_t MiB = 1u << 20;
constexpr size_t al(size_t x) { return (x + 4095) & ~(size_t)4095; }
constexpr size_t WS_CTL = 0, CTL_ZERO_BYTES = 1 * MiB;
constexpr size_t SZ_WIN = (size_t)NIN * D * 2, SZ_WOUT = (size_t)D * D * 2, SZ_WUP = (size_t)DFF2 * D * 2, SZ_WDN = (size_t)D * DFF * 2;
constexpr size_t WS_WIN = 1 * MiB;
constexpr size_t WS_WOUT = WS_WIN + 2 * SZ_WIN;
constexpr size_t WS_WUP = WS_WOUT + 2 * SZ_WOUT;
constexpr size_t WS_WDN = WS_WUP + 2 * SZ_WUP;
constexpr size_t WS_MOD = WS_WDN + 2 * SZ_WDN;
constexpr size_t WS_PART = al(WS_MOD + (size_t)2 * 2 * NMOD * 4);
constexpr size_t WS_WPOOL = al(WS_PART + (size_t)2 * 32 * 2 * NMOD * 4);
constexpr size_t WS_NAB = al(WS_WPOOL + (size_t)8 * 65536 * 2);
constexpr size_t WS_ROPE = al(WS_NAB + 64);
constexpr size_t WS_DT = al(WS_ROPE + 256 * 32 * 8);
constexpr size_t WS_H = al(WS_DT + (size_t)2 * R * 64 * 4);
constexpr size_t WS_MIX = al(WS_H + (size_t)R * D * 2);
constexpr size_t WS_X1 = al(WS_MIX + (size_t)R * D * 2);
constexpr size_t WS_X2 = al(WS_X1 + (size_t)R * D * 4);
constexpr size_t WS_ACT = al(WS_X2 + (size_t)R * D * 4);
constexpr size_t WS_OV = al(WS_ACT + (size_t)R * DFF * 2);
constexpr size_t WS_P = WS_OV;
constexpr size_t WS_XBC = al(WS_P + (size_t)R * NIN * 2);
constexpr size_t WS_Y = al(WS_XBC + (size_t)R * SSD_XBC * 2);
constexpr size_t WS_SEND = al(WS_Y + (size_t)R * SSD_DI * 4);
constexpr size_t WS_HIN = al(WS_SEND + (size_t)NCHUNK * 64 * 8192 * 4);
constexpr size_t WS_CHD = al(WS_HIN + (size_t)NCHUNK * 64 * 8192 * 2);
constexpr size_t WS_QN = al(WS_CHD + (size_t)NCHUNK * 64 * 4);
constexpr size_t WS_KN = al(WS_QN + (size_t)R * 1024 * 2);
constexpr size_t WS_PL = al(WS_KN + (size_t)R * 1024 * 2);
constexpr size_t WS_OV_END1 = al(WS_PL + (size_t)R * 1024 * 2);
constexpr size_t WS_E = WS_OV;
constexpr size_t WS_OV_END2 = al(WS_E + (size_t)(R / 64) * 4 * DFF2 * 4);
constexpr size_t WS_END = WS_OV_END1 > WS_OV_END2 ? WS_OV_END1 : WS_OV_END2;
constexpr size_t WS_SPK = WS_END;
constexpr size_t WS_END2 = WS_SPK + (size_t)16 * CTX * D * 4;
static_assert(WS_END2 <= (size_t)3072 * MiB, "d_ws map exceeds 3 GiB");

constexpr int CW_BAR = 4096;

constexpr int RING_OFF = 0, RING_BYTES = 144384;
constexpr int TIDTAB_OFF = RING_BYTES, TIDTAB_BYTES = 64 * 64 * 4;
constexpr int LDSCTL_OFF = TIDTAB_OFF + TIDTAB_BYTES, MISC_OFF = LDSCTL_OFF + 320;
constexpr int LDS_BYTES = 163840;

#define GAS __attribute__((address_space(1)))
#define LAS __attribute__((address_space(3)))
typedef unsigned short bf16;
typedef unsigned v4u __attribute__((ext_vector_type(4)));
typedef unsigned v2u __attribute__((ext_vector_type(2)));
typedef float f32x4 __attribute__((ext_vector_type(4)));
typedef float f32x2 __attribute__((ext_vector_type(2)));
typedef GAS unsigned gu32;
#define RLX_AGENT __ATOMIC_RELAXED, __HIP_MEMORY_SCOPE_AGENT
#define LDS_WAIT() asm volatile("s_waitcnt lgkmcnt(0)" ::: "memory")
#define VM_WAIT() asm volatile("s_waitcnt vmcnt(0)" ::: "memory")
__device__ __forceinline__ unsigned f2bf(float f) { unsigned u = __builtin_bit_cast(unsigned, f); return (u + 0x7fffu + ((u >> 16) & 1u)) >> 16; }
__device__ __forceinline__ unsigned pk2(float lo, float hi) { return f2bf(lo) | (f2bf(hi) << 16); }
__device__ __forceinline__ float bflo(unsigned w) { return __uint_as_float(w << 16); }
__device__ __forceinline__ float bfhi(unsigned w) { return __uint_as_float(w & 0xffff0000u); }
__device__ __forceinline__ float bf2f(bf16 b) { return __uint_as_float((unsigned)b << 16); }
__device__ __forceinline__ float silu_f(float v) { return v * __builtin_amdgcn_rcpf(1.f + __expf(-v)); }
__device__ __forceinline__ float wave_sum(float v) {
#pragma unroll
    for (int o = 1; o < 64; o <<= 1) v += __shfl_xor(v, o);
    return v;
}
__device__ __forceinline__ float wave_max(float v) {
#pragma unroll
    for (int o = 1; o < 64; o <<= 1) v = fmaxf(v, __shfl_xor(v, o));
    return v;
}

__device__ __forceinline__ int opaque_tid() {
    unsigned slot = (unsigned)__builtin_amdgcn_s_getreg((5 << 11) | 4) & 63u; asm volatile("" : "+s"(slot));
    unsigned lane; asm volatile("v_mbcnt_lo_u32_b32 %0, -1, 0\n\tv_mbcnt_hi_u32_b32 %0, -1, %0" : "=v"(lane));
    int t = *(const LAS int*)(size_t)((unsigned)TIDTAB_OFF + slot * 256u + lane * 4u); asm volatile("" : "+v"(t)); return t; }
#define XB_TMO      128
#define XB_XCNT(j)  (256  + 64 * (j))
#define XB_XSUB(j)  (1280 + 64 * (j))
#define XB_XGEN(j)  (2304 + 64 * (j))
#define XB_TOP      3328
#define XB_TOPGEN   3392
#define XCD_BAR_WORDS 3456
#define XB_SPIN_CAP (1u << 22)

__device__ __forceinline__ unsigned xb_ld(unsigned* p)              { return __hip_atomic_load(p, __ATOMIC_RELAXED, __HIP_MEMORY_SCOPE_AGENT); }
__device__ __forceinline__ unsigned xb_add(unsigned* p, unsigned v) { return __hip_atomic_fetch_add(p, v, __ATOMIC_RELAXED, __HIP_MEMORY_SCOPE_AGENT); }
__device__ __forceinline__ unsigned xb_xcc_id() { return (unsigned)__builtin_amdgcn_s_getreg((3 << 11) | 20) & 0xFu; }
#define XB_SPIN(cond, bar) do { unsigned _sp = 0; while (cond) { __builtin_amdgcn_s_sleep(1); \
    if ((++_sp & 255u) == 0u) { if (xb_ld(&(bar)[XB_TMO])) break; if (_sp > XB_SPIN_CAP) { atomicAdd(&(bar)[XB_TMO], 1u); break; } } } } while (0)

struct XcdBarrier { unsigned* bar; unsigned x; volatile LAS unsigned* st; };

__device__ __forceinline__ XcdBarrier xcd_barrier_post(unsigned* bar, volatile LAS unsigned* st) {
    XcdBarrier b; b.bar = bar; b.x = xb_xcc_id(); b.st = st;
    if (opaque_tid() == 0) (void)xb_add(&bar[XB_XCNT(b.x)], 1u);
    return b;
}
__device__ __forceinline__ void xcd_barrier_complete(unsigned* bar, unsigned x, unsigned& nloc, unsigned& nx) {
    const unsigned G = gridDim.x * gridDim.y * gridDim.z;
    unsigned sum, cnt, mine, sp = 0u;
    for (;;) {
        sum = 0u; cnt = 0u; mine = 0u;
#pragma unroll
        for (unsigned j = 0; j < 16; ++j) { const unsigned c = xb_ld(&bar[XB_XCNT(j)]); sum += c; cnt += (c > 0u) ? 1u : 0u; mine = (j == x) ? c : mine; }
        if (sum == G) break;
        __builtin_amdgcn_s_sleep(1);
        if ((++sp & 255u) == 0u) { if (xb_ld(&bar[XB_TMO])) break; if (sp > XB_SPIN_CAP) { atomicAdd(&bar[XB_TMO], 1u); break; } }
    }
    nloc = mine > 0u ? mine : 1u; nx = cnt > 0u ? cnt : 1u;
}
__device__ __forceinline__ void xcd_barrier(const XcdBarrier& b) {
    asm volatile("s_waitcnt vmcnt(0)" ::: "memory");
    __syncthreads();
    if (opaque_tid() == 0) {
        unsigned* bar = b.bar;
        __builtin_amdgcn_s_waitcnt(0);
        unsigned nloc = b.st[0], nx = b.st[1];
        if (nloc == 0u) { xcd_barrier_complete(bar, b.x, nloc, nx); b.st[0] = nloc; b.st[1] = nx; }
        const unsigned old = xb_add(&bar[XB_XSUB(b.x)], 1u);
        const unsigned gen = old / nloc;
        if (old + 1u == (gen + 1u) * nloc) {
            __builtin_amdgcn_fence(__ATOMIC_RELEASE, "agent");
            asm volatile("s_waitcnt vmcnt(0)" ::: "memory");
            const unsigned og = xb_add(&bar[XB_TOP], 1u);
            const unsigned tg = og / nx;
            if (og + 1u == (tg + 1u) * nx) xb_add(&bar[XB_TOPGEN], 1u);
            else XB_SPIN(xb_ld(&bar[XB_TOPGEN]) == tg, bar);
            __builtin_amdgcn_fence(__ATOMIC_ACQUIRE, "agent");
            xb_add(&bar[XB_XGEN(b.x)], 1u);
            asm volatile("s_waitcnt vmcnt(0)" ::: "memory");
        } else {
            XB_SPIN(xb_ld(&bar[XB_XGEN(b.x)]) == gen, bar);
            __builtin_amdgcn_fence(__ATOMIC_ACQUIRE, "agent");
            asm volatile("s_waitcnt vmcnt(0)" ::: "memory");
        }
    }
    __syncthreads();
}


struct Frame {
    LAS unsigned char* lds;
    volatile LAS unsigned* MISC;
    gu32* ctl;
    int G;
    __device__ __forceinline__ const unsigned char __attribute__((address_space(4)))* kargs() const { const unsigned char __attribute__((address_space(4)))* k = (const unsigned char __attribute__((address_space(4)))*)__builtin_amdgcn_kernarg_segment_ptr(); asm volatile("" : "+s"(k)); return k; }
    __device__ __forceinline__ unsigned char* ws_() const { return *(unsigned char* const __attribute__((address_space(4)))*)(kargs() + 208); }
    __device__ __forceinline__ float* out_() const { return *(float* const __attribute__((address_space(4)))*)(kargs() + 200); }
    __device__ __forceinline__ const float* in_(int i) const { return ((const float* const __attribute__((address_space(4)))*)kargs())[i]; }
};
enum { I_X = 0, I_C, I_CTX, I_CCTX, I_ADAW, I_ADAB, I_N1W, I_WIN, I_SCW, I_SCB, I_DTB, I_ALOG, I_SD, I_SNW, I_QNW, I_KNW, I_RPB, I_PW, I_PS, I_WOUT, I_N2W, I_WUP, I_MCW, I_MCB, I_WDN };

template <bool FFN_PERM = false, bool DEEP = false>
__device__ __forceinline__ void p0_transpose_item(const float* W, int K, int N, bf16* WT, LAS float* scr, int item, int lane) {
    const int nblk = N / 32, kb = item / nblk, nb = item % nblk, k0 = 64 * kb, n0 = 32 * nb;
    const int n0o = FFN_PERM ? (n0 < DFF ? 256 * (n0 / 128) + (n0 % 128) : 256 * ((n0 - DFF) / 128) + 128 + ((n0 - DFF) % 128)) : n0;
    if (DEEP) {
        float v[32];
#pragma unroll
        for (int i = 0; i < 32; ++i) { const int kk = 2 * i + (lane >> 5); v[i] = W[(size_t)(k0 + kk) * N + n0 + (lane & 31)]; }
#pragma unroll
        for (int i = 0; i < 32; ++i) { const int kk = 2 * i + (lane >> 5); scr[kk * 33 + (lane & 31)] = v[i]; }
    } else {
#pragma unroll 8
    for (int i = 0; i < 32; ++i) { const int kk = 2 * i + (lane >> 5); scr[kk * 33 + (lane & 31)] = W[(size_t)(k0 + kk) * N + n0 + (lane & 31)]; }
    }
    LDS_WAIT(); asm volatile("" ::: "memory");
    const int c = lane & 7;
#pragma unroll
    for (int j = 0; j < 4; ++j) { const int n = (lane >> 3) + 8 * j; const LAS float* s = scr + (8 * c) * 33 + n;
        v4u o; o.x = pk2(s[0 * 33], s[1 * 33]); o.y = pk2(s[2 * 33], s[3 * 33]); o.z = pk2(s[4 * 33], s[5 * 33]); o.w = pk2(s[6 * 33], s[7 * 33]);
        *(GAS v4u*)(WT + (size_t)(n0o + n) * K + k0 + 8 * c) = o; }
    LDS_WAIT(); asm volatile("" ::: "memory");
}

__device__ __forceinline__ void prologue_convert_win(Frame& F, int lane, int wave);
__device__ __forceinline__ void s0_prologue(Frame& F) {
    const int tid = opaque_tid(), lane = tid & 63, wave = __builtin_amdgcn_readfirstlane(tid >> 6); (void)lane; (void)wave;
    LAS float* scr = (LAS float*)(F.lds + RING_OFF + wave * 16384);
    const int gw = blockIdx.x * NWAVES + wave, NGW = F.G * NWAVES;
    prologue_convert_win(F, lane, wave);
    for (int it = gw; it < 8 * 32; it += NGW) p0_transpose_item(F.in_(I_PW) + (size_t)(it >> 5) * 65536, 256, 256, (bf16*)(F.ws_() + WS_WPOOL) + (size_t)(it >> 5) * 65536, scr, it & 31, lane);
    {
        const int gt = blockIdx.x * 512 + tid, NT = F.G * 512;
        constexpr int PADV = (NIN - IN_COLS) * D / 8;
        for (int i = gt; i < 2 * PADV; i += NT) { const int l = i / PADV, j = i % PADV;
            *((GAS v4u*)(F.ws_() + WS_WIN + l * SZ_WIN + (size_t)IN_COLS * D * 2) + j) = (v4u){0u, 0u, 0u, 0u}; }
        for (int i = gt; i < 256 * 32; i += NT) { const int pos = i >> 5, fi = i & 31;
            const double inv = exp2(-(double)(2 * fi) / 64.0 * 13.287712379549449); const double th = (double)pos * inv;
            double s, c; sincos(th, &s, &c);
            ((GAS f32x2*)(F.ws_() + WS_ROPE))[i] = (f32x2){(float)c, (float)s}; }
    }
    __syncthreads();
    {
        LAS float* sl = (LAS float*)(F.lds + RING_OFF);
        const float* cv = F.in_(I_C); const float* ccv = F.in_(I_CCTX);
        for (int it = blockIdx.x; it < 2 * 12 * 32; it += F.G) {
            const int l = it / 384, rem = it % 384, cb = rem / 32, kc = rem % 32;
            __syncthreads();
            if (tid < 256) { const int k = kc * 128 + (tid & 127); const float v = (tid < 128) ? cv[k] : ccv[k]; sl[tid] = silu_f(v); }
            __syncthreads();
            const int col = cb * 2048 + tid * 4;
            const float* wp = F.in_(I_ADAW) + ((size_t)l * D + (size_t)kc * 128) * NMOD + col;
            f32x4 a0 = (f32x4){0.f, 0.f, 0.f, 0.f}, a1 = a0;
#pragma unroll 16
            for (int k = 0; k < 128; ++k) { const f32x4 w = *(const GAS f32x4*)(wp + (size_t)k * NMOD); a0 += sl[k] * w; a1 += sl[128 + k] * w; }
            float* part = (float*)(F.ws_() + WS_PART);
            *(GAS f32x4*)(part + ((size_t)(l * 32 + kc) * 2 + 0) * NMOD + col) = a0;
            *(GAS f32x4*)(part + ((size_t)(l * 32 + kc) * 2 + 1) * NMOD + col) = a1;
        }
    }
}
constexpr int CW_Q = 64;
constexpr int Q_CH = 4;
struct TrItem { const float* src; bf16* dst; int K, N; };
template <int L>
__device__ __forceinline__ TrItem spare_item(Frame& F, int it) {
    constexpr int I_OUT = L < 0 ? 0 : (D / 64) * (D / 32), I_DN = L < 0 ? 0 : (DFF / 64) * (D / 32), I_UP = L < 0 ? 0 : (D / 64) * (DFF2 / 32);
    TrItem t;
    if (it < I_OUT) { const int kb = it / (D / 32), nb = it % (D / 32); t.K = D; t.N = D;
        t.src = F.in_(I_WOUT) + (size_t)L * D * D + (size_t)(64 * kb) * D + 32 * nb; t.dst = (bf16*)(F.ws_() + WS_WOUT + L * SZ_WOUT) + (size_t)(32 * nb) * D + 64 * kb; }
    else if (it < I_OUT + I_DN) { const int r = it - I_OUT, kb = r / (D / 32), nb = r % (D / 32); t.K = DFF; t.N = D;
        t.src = F.in_(I_WDN) + (size_t)L * DFF * D + (size_t)(64 * kb) * D + 32 * nb; t.dst = (bf16*)(F.ws_() + WS_WDN + L * SZ_WDN) + (size_t)(32 * nb) * DFF + 64 * kb; }
    else if (it < I_OUT + I_DN + I_UP) { const int r = it - I_OUT - I_DN, kb = r / (DFF2 / 32), nb = r % (DFF2 / 32), n0 = 32 * nb; t.K = D; t.N = DFF2;
        const int n0o = n0 < DFF ? 256 * (n0 / 128) + (n0 % 128) : 256 * ((n0 - DFF) / 128) + 128 + ((n0 - DFF) % 128);
        t.src = F.in_(I_WUP) + (size_t)L * D * DFF2 + (size_t)(64 * kb) * DFF2 + n0; t.dst = (bf16*)(F.ws_() + WS_WUP + L * SZ_WUP) + (size_t)n0o * D + 64 * kb; }
    else { const int r = it - I_OUT - I_DN - I_UP, kb = r / (IN_COLS / 32), nb = r % (IN_COLS / 32); t.K = D; t.N = IN_COLS;
        t.src = F.in_(I_WIN) + (size_t)(L + 1) * D * IN_COLS + (size_t)(64 * kb) * IN_COLS + 32 * nb; t.dst = (bf16*)(F.ws_() + WS_WIN + (L + 1) * SZ_WIN) + (size_t)(32 * nb) * D + 64 * kb; }
    return t;
}
__device__ __forceinline__ void tr_load4(const TrItem& t, int lane, f32x4 (&v)[8]) {
    const float* p = t.src + (size_t)(8 * (lane >> 3)) * t.N + (lane & 7) * 4;
#pragma unroll
    for (int i = 0; i < 8; ++i) v[i] = __builtin_nontemporal_load((const f32x4*)(p + (size_t)i * t.N));
}
__device__ __forceinline__ void tr_store4(const TrItem& t, int lane, const f32x4 (&v)[8]) {
    bf16* d = t.dst + (size_t)(4 * (lane & 7)) * t.K + 8 * (lane >> 3);
#pragma unroll
    for (int e = 0; e < 4; ++e) { v4u o; o.x = pg8::cvt_pk_bf16(v[0][e], v[1][e]); o.y = pg8::cvt_pk_bf16(v[2][e], v[3][e]); o.z = pg8::cvt_pk_bf16(v[4][e], v[5][e]); o.w = pg8::cvt_pk_bf16(v[6][e], v[7][e]);
        __builtin_nontemporal_store(o, (v4u*)(d + (size_t)e * t.K)); }
}
__device__ __forceinline__ int q_grab(gu32* ctr, int lane) {
    unsigned q = 0; if (lane == 0) q = __hip_atomic_fetch_add((unsigned*)ctr, 1u, __ATOMIC_RELAXED, __HIP_MEMORY_SCOPE_AGENT);
    return __builtin_amdgcn_readfirstlane((int)q) * Q_CH;
}
template <int L>
__device__ __forceinline__ void spare_convert(Frame& F) {
    const int tid = opaque_tid(), lane = tid & 63;
    constexpr int NI = (D / 64) * (D / 32) + (DFF / 64) * (D / 32) + (D / 64) * (DFF2 / 32) + (L + 1 < DEPTH ? (D / 64) * (IN_COLS / 32) : 0);
    static_assert(((D / 64) * (D / 32)) % Q_CH == 0 && ((DFF / 64) * (D / 32)) % Q_CH == 0 && ((D / 64) * (DFF2 / 32)) % Q_CH == 0 && ((D / 64) * (IN_COLS / 32)) % Q_CH == 0, "chunks must not straddle matrices");
    gu32* ctr = F.ctl + CW_Q + 64 * L;
    int cur = q_grab(ctr, lane), nxt = q_grab(ctr, lane);
    f32x4 v[Q_CH][8];
    if (cur < NI) {
#pragma unroll
        for (int s = 0; s < Q_CH; ++s) { const TrItem t = spare_item<L>(F, cur + s); tr_load4(t, lane, v[s]); }
    }
#pragma unroll
    for (int s = 0; s < Q_CH; ++s)
#pragma unroll
        for (int i = 0; i < 8; ++i) asm volatile("" : "+v"(v[s][i]));
#pragma unroll 1
    while (cur < NI) {
        unsigned raw = 0; if (lane == 0) asm volatile("global_atomic_add %0, %1, %2, off sc0" : "=v"(raw) : "v"((unsigned long long)(size_t)ctr), "v"(1u) : "memory");
        const int ln = nxt < NI ? nxt : cur;
#pragma unroll
        for (int s = 0; s < Q_CH; ++s) {
            const TrItem tc = spare_item<L>(F, cur + s);
            tr_store4(tc, lane, v[s]);
            asm volatile("" ::: "memory");
            { const TrItem tn = spare_item<L>(F, ln + s); tr_load4(tn, lane, v[s]); }
            asm volatile("" ::: "memory");
        }
        asm volatile("s_waitcnt vmcnt(40)" : "+v"(raw) :: "memory");
        cur = nxt; nxt = __builtin_amdgcn_readfirstlane((int)raw) * Q_CH;
    }
}
__device__ __forceinline__ void prologue_convert_win(Frame& F, int lane, int wave) {
    constexpr int NI = (D / 64) * (IN_COLS / 32);
    static_assert(NI % Q_CH == 0, "whole chunks");
    const int step = F.G * NWAVES * Q_CH;
    int cur = (wave * F.G + (int)blockIdx.x) * Q_CH;
    f32x4 v[Q_CH][8];
    if (cur < NI) {
#pragma unroll
        for (int s = 0; s < Q_CH; ++s) { const TrItem t = spare_item<-1>(F, cur + s); tr_load4(t, lane, v[s]); }
    }
#pragma unroll
    for (int s = 0; s < Q_CH; ++s)
#pragma unroll
        for (int i = 0; i < 8; ++i) asm volatile("" : "+v"(v[s][i]));
#pragma unroll 1
    while (cur < NI) {
        const int nxt = cur + step, ln = nxt < NI ? nxt : cur;
#pragma unroll
        for (int s = 0; s < Q_CH; ++s) {
            const TrItem tc = spare_item<-1>(F, cur + s);
            tr_store4(tc, lane, v[s]);
            asm volatile("" ::: "memory");
            { const TrItem tn = spare_item<-1>(F, ln + s); tr_load4(tn, lane, v[s]); }
            asm volatile("" ::: "memory");
        }
        cur = nxt;
    }
}
__device__ __forceinline__ void s1_ada_finalize(Frame& F) {
    const int tid = opaque_tid(), lane = tid & 63, wave = __builtin_amdgcn_readfirstlane(tid >> 6); (void)lane; (void)wave;
    const int gt = blockIdx.x * 512 + tid, NT = F.G * 512;
    const float* part = (const float*)(F.ws_() + WS_PART); float* mod = (float*)(F.ws_() + WS_MOD);
    for (int o = gt; o < 2 * 2 * NMOD; o += NT) { const int l = o / (2 * NMOD), w = (o / NMOD) & 1, n = o % NMOD;
        float s = F.in_(I_ADAB)[l * NMOD + n];
        for (int kc = 0; kc < 32; ++kc) s += part[((size_t)(l * 32 + kc) * 2 + w) * NMOD + n];
        mod[o] = s; }
    if (blockIdx.x == 0 && tid < 16) { const int l = tid >> 3, h = tid & 7; float mq = 0.f, mk = 0.f, mb = 0.f;
        for (int i = 0; i < 128; ++i) { mq = fmaxf(mq, fabsf(F.in_(I_QNW)[l * 128 + i])); mk = fmaxf(mk, fabsf(F.in_(I_KNW)[l * 128 + i])); }
        for (int i = 0; i < 15 * 31; ++i) mb = fmaxf(mb, fabsf(F.in_(I_RPB)[(size_t)(l * 8 + h) * 465 + i]));
        ((float*)(F.ws_() + WS_NAB))[tid] = 128.f * mq * mk * 0.08838834764831845f * 1.02f + mb; }
}
__device__ __forceinline__ const float* modp(Frame& F, int l, int which, int j) { return (const float*)(F.ws_() + WS_MOD) + (size_t)(l * 2 + which) * NMOD + j * D; }

__device__ __forceinline__ void norm_finish_row(const f32x4 (&v)[16], int r, const LAS float* Asel, const LAS float* Bsel, bf16* H, int lane) {
    float s = 0.f;
#pragma unroll
    for (int j = 0; j < 16; ++j) s += (v[j].x * v[j].x + v[j].y * v[j].y) + (v[j].z * v[j].z + v[j].w * v[j].w);
    const float rstd = rsqrtf(wave_sum(s) * (1.f / D) + RMS_EPS);
    GAS v2u* o8 = (GAS v2u*)(H + (size_t)r * D) + lane;
#pragma unroll
    for (int j = 0; j < 16; ++j) { const int e = j * 256 + lane * 4;
        const f32x4 a = *(const LAS f32x4*)(Asel + e), b = *(const LAS f32x4*)(Bsel + e);
        const f32x4 y = v[j] * rstd * a + b;
        v2u o; o.x = pk2(y.x, y.y); o.y = pk2(y.z, y.w); o8[64 * j] = o;
        if ((j & 3) == 3) asm volatile("" ::: "memory"); }
}
template <bool LBF>
__device__ __forceinline__ void norm_mod_phase(Frame& F, const float* src_c, const void* src_l, const float* nw, int l, int jsh, int jsc, const float* spk = nullptr, const float* spk_gate = nullptr, float* xst = nullptr, int r_begin = 0) {
    const int tid = opaque_tid(), lane = tid & 63, wave = __builtin_amdgcn_readfirstlane(tid >> 6);
    const int gw = blockIdx.x * NWAVES + wave, NGW = F.G * NWAVES;
    bf16* H = (bf16*)(F.ws_() + WS_H);
    LAS float* AB = (LAS float*)(F.lds + RING_OFF);
    __syncthreads();
    for (int e = tid; e < D; e += 512) { const float w = nw[e];
        AB[e] = w * (1.f + modp(F, l, 0, jsc)[e]); AB[D + e] = modp(F, l, 0, jsh)[e];
        AB[2 * D + e] = w * (1.f + modp(F, l, 1, jsc)[e]); AB[3 * D + e] = modp(F, l, 1, jsh)[e]; }
    __syncthreads();
    if (spk) for (int r = gw; r < CTX; r += NGW) {
        const GAS f32x4* xr = (const GAS f32x4*)(src_c + (size_t)r * D) + lane;
        f32x4 v[16];
#pragma unroll
        for (int j = 0; j < 16; ++j) { f32x4 a = (f32x4){0.f, 0.f, 0.f, 0.f};
#pragma unroll 1
            for (int k4 = 0; k4 < 16; k4 += 4) { f32x4 t[4];
#pragma unroll
                for (int k = 0; k < 4; ++k) t[k] = *((const GAS f32x4*)(spk + ((size_t)(k4 + k) * CTX + r) * D) + lane + 64 * j);
                a += (t[0] + t[1]) + (t[2] + t[3]); }
            const f32x4 gt = *((const GAS f32x4*)spk_gate + lane + 64 * j);
            const f32x4 x = xr[64 * j] + gt * a; *((GAS f32x4*)(xst + (size_t)r * D) + lane + 64 * j) = x; v[j] = x; }
        norm_finish_row(v, r, AB + 2 * D, AB + 3 * D, H, lane);
    }
    const int rb = spk ? (r_begin > CTX ? r_begin : CTX) : r_begin;
#define NORM_LOAD(V, r) do { if (LBF && (r) >= CTX) { const GAS v2u* xh_ = (const GAS v2u*)((const bf16*)src_l + (size_t)((r) - CTX) * D) + lane; \
            _Pragma("unroll") for (int j = 0; j < 16; ++j) { const v2u w_ = xh_[64 * j]; V[j] = (f32x4){bflo(w_.x), bfhi(w_.x), bflo(w_.y), bfhi(w_.y)}; } } \
        else { const GAS f32x4* xr_ = (const GAS f32x4*)(((r) < CTX) ? src_c + (size_t)(r) * D : (const float*)src_l + (size_t)((r) - CTX) * D) + lane; \
            _Pragma("unroll") for (int j = 0; j < 16; ++j) V[j] = xr_[64 * j]; } } while (0)
#define NORM_FIN(V, r) norm_finish_row(V, r, (r) < CTX ? AB + 2 * D : AB, (r) < CTX ? AB + 3 * D : AB + D, H, lane)
    f32x4 va[16], vb[16];
    int r = rb + gw;
    if (r < R) NORM_LOAD(va, r);
#pragma unroll 1
    while (r < R) {
        const int r1 = r + NGW, r2 = r1 + NGW;
        if (r1 < R) NORM_LOAD(vb, r1);
        NORM_FIN(va, r);
        if (r1 >= R) break;
        if (r2 < R) NORM_LOAD(va, r2);
        NORM_FIN(vb, r1);
        r = r2;
    }
#undef NORM_LOAD
#undef NORM_FIN
    __syncthreads();
}

__device__ __forceinline__ void unpack8(const v4u x, float (&f)[8]) { f[0] = bflo(x.x); f[1] = bfhi(x.x); f[2] = bflo(x.y); f[3] = bfhi(x.y); f[4] = bflo(x.z); f[5] = bfhi(x.z); f[6] = bflo(x.w); f[7] = bfhi(x.w); }
__device__ __forceinline__ void prep_conv(Frame& F, int l, int tid) {
    const bf16* P = (const bf16*)(F.ws_() + WS_P); bf16* XB = (bf16*)(F.ws_() + WS_XBC);
    const float* cw = F.in_(I_SCW) + (size_t)l * 5 * SSD_XBC; const float* cb = F.in_(I_SCB) + (size_t)l * SSD_XBC;
    constexpr int NCHK = SSD_XBC / 8;
    for (int it = blockIdx.x * 512 + tid; it < (R / 64) * NCHK; it += F.G * 512) {
        const int sg = it / NCHK, ch = (it % NCHK) * 8, r0 = sg * 64;
        const int seg_lo = r0 < CTX ? 0 : CTX, seg_hi = r0 < CTX ? CTX : R;
        float w[5][8], bb[8];
#pragma unroll
        for (int k = 0; k < 5; ++k) { const f32x4 a = *(const GAS f32x4*)(cw + k * SSD_XBC + ch), b = *(const GAS f32x4*)(cw + k * SSD_XBC + ch + 4);
            w[k][0] = a.x; w[k][1] = a.y; w[k][2] = a.z; w[k][3] = a.w; w[k][4] = b.x; w[k][5] = b.y; w[k][6] = b.z; w[k][7] = b.w; }
        { const f32x4 a = *(const GAS f32x4*)(cb + ch), b = *(const GAS f32x4*)(cb + ch + 4); bb[0] = a.x; bb[1] = a.y; bb[2] = a.z; bb[3] = a.w; bb[4] = b.x; bb[5] = b.y; bb[6] = b.z; bb[7] = b.w; }
        const bf16* src = P + OFF_XBC + ch;
        const v4u zero = (v4u){0u, 0u, 0u, 0u};
#define PREP_LD(rr) (((rr) >= seg_lo && (rr) < seg_hi) ? *(const GAS v4u*)(src + (size_t)(rr) * NIN) : zero)
        float x0[8], x1[8], x2[8], x3[8], x4[8];
        unpack8(PREP_LD(r0 - 2), x0); unpack8(PREP_LD(r0 - 1), x1); unpack8(PREP_LD(r0), x2); unpack8(PREP_LD(r0 + 1), x3);
        v4u na[5], nb[5];
#define PREP_LD5(buf, rb) do { _Pragma("unroll") for (int k = 0; k < 5; ++k) buf[k] = PREP_LD((rb) + k); } while (0)
#define PREP_STEP(a, b, c, d, e, i, raw) do { const int r = r0 + (i); unpack8(raw, e); \
            if ((i) < 64) { float o[8]; _Pragma("unroll") for (int q = 0; q < 8; ++q) { const float v = bb[q] + w[0][q] * a[q] + w[1][q] * b[q] + w[2][q] * c[q] + w[3][q] * d[q] + w[4][q] * e[q]; o[q] = silu_f(v); } \
                v4u ov; ov.x = pk2(o[0], o[1]); ov.y = pk2(o[2], o[3]); ov.z = pk2(o[4], o[5]); ov.w = pk2(o[6], o[7]); *(GAS v4u*)(XB + (size_t)r * SSD_XBC + ch) = ov; } } while (0)
#define PREP_STEP5(i, buf) do { PREP_STEP(x0, x1, x2, x3, x4, (i), buf[0]); PREP_STEP(x1, x2, x3, x4, x0, (i) + 1, buf[1]); PREP_STEP(x2, x3, x4, x0, x1, (i) + 2, buf[2]); \
            PREP_STEP(x3, x4, x0, x1, x2, (i) + 3, buf[3]); PREP_STEP(x4, x0, x1, x2, x3, (i) + 4, buf[4]); } while (0)
        PREP_LD5(na, r0 + 2);
#pragma unroll 1
        for (int i = 0; i < 60; i += 10) {
            PREP_LD5(nb, r0 + i + 7); PREP_STEP5(i, na);
            PREP_LD5(na, r0 + i + 12); PREP_STEP5(i + 5, nb);
        }
        PREP_STEP5(60, na);
#undef PREP_STEP5
#undef PREP_LD5
#undef PREP_STEP
#undef PREP_LD
    }
}
__device__ __forceinline__ void prep_rows(Frame& F, int l, int lane, int wave) {
    const int gw = blockIdx.x * NWAVES + wave, NGW = F.G * NWAVES;
    const bf16* P = (const bf16*)(F.ws_() + WS_P);
    bf16* QN = (bf16*)(F.ws_() + WS_QN); bf16* KN = (bf16*)(F.ws_() + WS_KN); bf16* PL = (bf16*)(F.ws_() + WS_PL);
    float* DT = (float*)(F.ws_() + WS_DT); float* DA = DT + (size_t)R * 64;
    const GAS f32x2* rope = (const GAS f32x2*)(F.ws_() + WS_ROPE);
    const int hq = lane >> 2, qq = lane & 3, hf = qq >> 1, sb = qq & 1, dA = 64 * hf + 16 * sb;
    const bool isk = hq >= 8;
    float wa[16], wb[16];
    { const float* w = (isk ? F.in_(I_KNW) : F.in_(I_QNW)) + l * 128;
#pragma unroll
      for (int j = 0; j < 16; ++j) { wa[j] = w[dA + j]; wb[j] = w[dA + 32 + j]; } }
    const float dtb = F.in_(I_DTB)[l * 64 + lane], aneg = -__expf(F.in_(I_ALOG)[l * 64 + lane]);
#pragma unroll 1
    for (int r = gw; r < R; r += NGW) {
        const bool isc = r < CTX; const int seg_lo = isc ? 0 : CTX, seg_hi = isc ? CTX : R;
        { const float v = bf2f(P[(size_t)r * NIN + OFF_DT + lane]) + dtb;
          const float dt = fmaxf(v, 0.f) + log1pf(__expf(-fabsf(v)));
          DT[(size_t)r * 64 + lane] = dt; DA[(size_t)r * 64 + lane] = dt * aneg; }
        {
            const bf16* src = P + (size_t)r * NIN + (isk ? OFF_K + (hq - 8) * 128 : OFF_Q + hq * 128) + dA;
            const v4u a0 = *(const GAS v4u*)(src), a1 = *(const GAS v4u*)(src + 8), b0 = *(const GAS v4u*)(src + 32), b1 = *(const GAS v4u*)(src + 40);
            float a[16], b[16];
            { float t[8]; unpack8(a0, t);
#pragma unroll
              for (int j = 0; j < 8; ++j) a[j] = t[j]; unpack8(a1, t);
#pragma unroll
              for (int j = 0; j < 8; ++j) a[8 + j] = t[j]; unpack8(b0, t);
#pragma unroll
              for (int j = 0; j < 8; ++j) b[j] = t[j]; unpack8(b1, t);
#pragma unroll
              for (int j = 0; j < 8; ++j) b[8 + j] = t[j]; }
            float ss = 0.f;
#pragma unroll
            for (int j = 0; j < 16; ++j) ss += a[j] * a[j] + b[j] * b[j];
            ss += __shfl_xor(ss, 1); ss += __shfl_xor(ss, 2);
            const float rstd = rsqrtf(ss * (1.f / 128.f) + RMS_EPS);
            const int t = r - CTX, pos = isc ? 0 : (hf == 0 ? t / GRID_W : t % GRID_W);
            const GAS f32x4* rp = (const GAS f32x4*)(rope + pos * 32 + 16 * sb);
            unsigned oa[8], ob[8];
#pragma unroll
            for (int j2 = 0; j2 < 8; ++j2) {
                const f32x4 cs2 = isc ? (f32x4){1.f, 0.f, 1.f, 0.f} : rp[j2];
                const float u0 = a[2 * j2] * rstd * wa[2 * j2], v0 = b[2 * j2] * rstd * wb[2 * j2], u1 = a[2 * j2 + 1] * rstd * wa[2 * j2 + 1], v1 = b[2 * j2 + 1] * rstd * wb[2 * j2 + 1];
                oa[j2] = pk2(u0 * cs2.x - v0 * cs2.y, u1 * cs2.z - v1 * cs2.w);
                ob[j2] = pk2(v0 * cs2.x + u0 * cs2.y, v1 * cs2.z + u1 * cs2.w); }
            bf16* dst = (isk ? KN : QN) + (size_t)r * 1024 + (hq & 7) * 128 + dA;
            *(GAS v4u*)(dst) = (v4u){oa[0], oa[1], oa[2], oa[3]}; *(GAS v4u*)(dst + 8) = (v4u){oa[4], oa[5], oa[6], oa[7]};
            *(GAS v4u*)(dst + 32) = (v4u){ob[0], ob[1], ob[2], ob[3]}; *(GAS v4u*)(dst + 40) = (v4u){ob[4], ob[5], ob[6], ob[7]};
        }
#pragma unroll 1
        for (int it = 0; it < 2; ++it) {
            const int ch = it * 512 + lane * 8, g = ch >> 8, hw = 1 << g;
            const int lo = max(r - hw, seg_lo), hi = min(r + hw, seg_hi);
            const bf16* src = P + OFF_POOL + ch;
            v4u xv[16];
#pragma unroll
            for (int k = 0; k < 16; ++k) { const int rr = r - hw + k; xv[k] = (k < 2 * hw && rr >= seg_lo && rr < seg_hi) ? *(const GAS v4u*)(src + (size_t)rr * NIN) : (v4u){0u, 0u, 0u, 0u}; }
            float a[8] = {0.f, 0.f, 0.f, 0.f, 0.f, 0.f, 0.f, 0.f};
#pragma unroll
            for (int k = 0; k < 16; ++k) { a[0] += bflo(xv[k].x); a[1] += bfhi(xv[k].x); a[2] += bflo(xv[k].y); a[3] += bfhi(xv[k].y); a[4] += bflo(xv[k].z); a[5] += bfhi(xv[k].z); a[6] += bflo(xv[k].w); a[7] += bfhi(xv[k].w); }
            const float ic = 1.f / (float)(hi - lo);
            const v4u x = *(const GAS v4u*)(src + (size_t)r * NIN);
            v4u o; o.x = pk2(a[0] * ic - bflo(x.x), a[1] * ic - bfhi(x.x)); o.y = pk2(a[2] * ic - bflo(x.y), a[3] * ic - bfhi(x.y));
            o.z = pk2(a[4] * ic - bflo(x.z), a[5] * ic - bfhi(x.z)); o.w = pk2(a[6] * ic - bflo(x.w), a[7] * ic - bfhi(x.w));
            *(GAS v4u*)(PL + (size_t)r * 1024 + ch) = o;
        }
    }
}
__device__ __forceinline__ void prep_phase(Frame& F, int l) {
    const int tid = opaque_tid(), lane = tid & 63, wave = __builtin_amdgcn_readfirstlane(tid >> 6);
    prep_conv(F, l, tid);
    prep_rows(F, l, lane, wave);
}

typedef short bf16x8v __attribute__((ext_vector_type(8)));
typedef short bf16x4v __attribute__((ext_vector_type(4)));
constexpr int TS = 272, XS = 144;
constexpr int L_TB = 0, L_TC = 34816, L_XF = 69632, L_XB = 88064, L_HF = 106496, L_HB = 123904, L_CS = 141312;
static_assert(L_CS + 6 * 512 <= RING_BYTES, "SSD LDS map");
__device__ __forceinline__ bf16x4v ds_tr16(unsigned addr) { bf16x4v r; asm volatile("ds_read_b64_tr_b16 %0, %1" : "=v"(r) : "v"(addr) : "memory"); return r; }
__device__ __forceinline__ bf16x8v cat8(bf16x4v a, bf16x4v b) { return __builtin_shufflevector(a, b, 0, 1, 2, 3, 4, 5, 6, 7); }
#define TR_WAIT4(a, b, c, d) asm volatile("s_waitcnt lgkmcnt(0)" : "+v"(a), "+v"(b), "+v"(c), "+v"(d) :: "memory")
__device__ __forceinline__ int chunk_order(int d, int s) { return d == 0 ? s : (s < 2 ? 1 - s : (NCHUNK - 1) - (s - 2)); }

__device__ __forceinline__ int vwg(int G) { const int b = (int)blockIdx.x; return (G % 8 == 0) ? (b & 7) * (G >> 3) + (b >> 3) : b; }
struct SsdPre { v4u b[4], c[4], hh[4], x[2]; float a0, a1, t0, t1; };
__device__ __forceinline__ v4u ldg16(const void* ubase, unsigned voff) { return *(const GAS v4u*)((const GAS unsigned char*)ubase + voff); }
template <bool OUT>
__device__ __forceinline__ void ssd_fetch(Frame& F, SsdPre& p, int c, int h, int tid, int lane, int wave) {
    const int r0 = c * 128, g = h >> 3;
    const bf16* XBr = (const bf16*)(F.ws_() + WS_XBC) + (size_t)r0 * SSD_XBC;
    const unsigned offT = (unsigned)(((tid >> 4) * SSD_XBC + (tid & 15) * 8) * 2);
    const unsigned offX = (unsigned)(((tid >> 3) * SSD_XBC + (tid & 7) * 8) * 2);
#pragma unroll
    for (int i = 0; i < 4; ++i) {
        p.b[i] = ldg16(XBr + (size_t)(32 * i) * SSD_XBC + SSD_DI + g * 128, offT);
        if (OUT) p.c[i] = ldg16(XBr + (size_t)(32 * i) * SSD_XBC + SSD_DI + SSD_GN + g * 128, offT); }
#pragma unroll
    for (int i = 0; i < 2; ++i) p.x[i] = ldg16(XBr + (size_t)(64 * i) * SSD_XBC + h * 64, offX);
    if (wave < 2) { const int dcol = wave * 32 + h; const float* DT = (const float*)(F.ws_() + WS_DT); const float* DA = DT + (size_t)R * 64;
        int ln = lane; asm volatile("" : "+v"(ln));
        p.a0 = DA[(size_t)(r0 + 2 * ln) * 64 + dcol]; p.a1 = DA[(size_t)(r0 + 2 * ln + 1) * 64 + dcol];
        p.t0 = DT[(size_t)(r0 + 2 * ln) * 64 + dcol]; p.t1 = DT[(size_t)(r0 + 2 * ln + 1) * 64 + dcol]; }
}
__device__ __forceinline__ void ssd_fetch_h(Frame& F, SsdPre& p, int c, int h, int tid) {
    const bf16* HIN = (const bf16*)(F.ws_() + WS_HIN);
    const unsigned offH = (unsigned)(((tid >> 4) * 128 + (tid & 15) * 8) * 2);
#pragma unroll
    for (int i = 0; i < 4; ++i) p.hh[i] = ldg16(HIN + ((size_t)(c * 64 + (i >> 1) * 32 + h) * 64 + 32 * (i & 1)) * 128, offH);
}
__device__ __forceinline__ void ssd_commit_h(Frame& F, const SsdPre& p, int tid) {
#pragma unroll
    for (int i = 0; i < 4; ++i) { const int q = tid + 512 * i, d = q >> 10, qq = q & 1023, row = qq >> 4, ch = qq & 15;
        *(LAS v4u*)(F.lds + (d ? L_HB : L_HF) + row * TS + ch * 16) = p.hh[i]; }
}
template <bool STATES>
__device__ __forceinline__ void ssd_stage_cs(Frame& F, const SsdPre& p, int c, int h, int lane, int wave) {
    if (wave < 2) {
        const int d = wave, dcol = d * 32 + h;
        LAS float* cs = (LAS float*)(F.lds + L_CS);
        const float a0 = p.a0, a1 = p.a1, t0 = p.t0, t1 = p.t1;
        float sc = a0 + a1;
#pragma unroll
        for (int o = 1; o < 64; o <<= 1) { const float v = __shfl_up(sc, o); if (lane >= o) sc += v; }
        const float tot = __shfl(sc, 63);
        const float c1 = sc, c0 = sc - a1;
        float k0, k1, e0, e1;
        if (d == 0) { k0 = c0; k1 = c1; e0 = STATES ? t0 * __expf(tot - c0) : __expf(c0); e1 = STATES ? t1 * __expf(tot - c1) : __expf(c1); }
        else { k0 = tot - c0 + a0; k1 = tot - c1 + a1; e0 = STATES ? t0 * __expf(tot - k0) : __expf(k0); e1 = STATES ? t1 * __expf(tot - k1) : __expf(k1); }
        cs[d * 128 + 2 * lane] = k0; cs[d * 128 + 2 * lane + 1] = k1;
        cs[(2 + d) * 128 + 2 * lane] = e0; cs[(2 + d) * 128 + 2 * lane + 1] = e1;
        cs[(4 + d) * 128 + 2 * lane] = t0; cs[(4 + d) * 128 + 2 * lane + 1] = t1;
        if (STATES && lane == 0) ((float*)(F.ws_() + WS_CHD))[c * 64 + dcol] = __expf(tot);
    }
}
template <bool OUT>
__device__ __forceinline__ void ssd_commit_tiles(Frame& F, const SsdPre& p, int tid) {
#pragma unroll
    for (int i = 0; i < 4; ++i) { const int q = tid + 512 * i, row = q >> 4, ch = q & 15;
        *(LAS v4u*)(F.lds + L_TB + row * TS + ch * 16) = p.b[i];
        if (OUT) *(LAS v4u*)(F.lds + L_TC + row * TS + ch * 16) = p.c[i]; }
}
__device__ __forceinline__ void ssd_commit_x(Frame& F, const SsdPre& p, const LAS float* sf, const LAS float* sb, int tid) {
#pragma unroll
    for (int i = 0; i < 2; ++i) { const int q = tid + 512 * i, row = q >> 3, ch = q & 7;
        const v4u x = p.x[i];
        const float wf = sf[row], wb = sb[row];
        const float xf[8] = {bflo(x.x), bfhi(x.x), bflo(x.y), bfhi(x.y), bflo(x.z), bfhi(x.z), bflo(x.w), bfhi(x.w)};
        v4u of, ob;
        of.x = pk2(xf[0] * wf, xf[1] * wf); of.y = pk2(xf[2] * wf, xf[3] * wf); of.z = pk2(xf[4] * wf, xf[5] * wf); of.w = pk2(xf[6] * wf, xf[7] * wf);
        ob.x = pk2(xf[0] * wb, xf[1] * wb); ob.y = pk2(xf[2] * wb, xf[3] * wb); ob.z = pk2(xf[4] * wb, xf[5] * wb); ob.w = pk2(xf[6] * wb, xf[7] * wb);
        *(LAS v4u*)(F.lds + L_XF + row * XS + ch * 16) = of; *(LAS v4u*)(F.lds + L_XB + row * XS + ch * 16) = ob; }
}

__device__ __forceinline__ void ssd_states_compute(Frame& F, int c, int h, int tid, int lane, int wave) {
    const int pt = wave & 3, nh = wave >> 2, p0 = 16 * pt, lg = lane >> 4, q4 = (lane & 15) >> 2, pp = lane & 3;
    const unsigned ldsb = (unsigned)(size_t)F.lds;
    f32x4 accf[4], accb[4];
#pragma unroll
    for (int i = 0; i < 4; ++i) { accf[i] = (f32x4){0.f, 0.f, 0.f, 0.f}; accb[i] = (f32x4){0.f, 0.f, 0.f, 0.f}; }
#pragma unroll
    for (int ks = 0; ks < 4; ++ks) {
        const int jrow = 32 * ks + 8 * lg + q4;
        const unsigned ax = ldsb + (unsigned)(jrow * XS + (p0 + 4 * pp) * 2);
        bf16x4v afl = ds_tr16(ax + L_XF), afh = ds_tr16(ax + L_XF + 4 * XS), abl = ds_tr16(ax + L_XB), abh = ds_tr16(ax + L_XB + 4 * XS);
        bf16x4v bl[4], bh[4];
#pragma unroll
        for (int nt = 0; nt < 4; ++nt) { const unsigned ab = ldsb + (unsigned)(L_TB + jrow * TS + (nh * 64 + 16 * nt + 4 * pp) * 2); bl[nt] = ds_tr16(ab); bh[nt] = ds_tr16(ab + 4 * TS); }
        TR_WAIT4(afl, afh, abl, abh); TR_WAIT4(bl[0], bh[0], bl[1], bh[1]); TR_WAIT4(bl[2], bh[2], bl[3], bh[3]);
        const bf16x8v af = cat8(afl, afh), ab8 = cat8(abl, abh);
#pragma unroll
        for (int nt = 0; nt < 4; ++nt) { const bf16x8v b8 = cat8(bl[nt], bh[nt]);
            accf[nt] = __builtin_amdgcn_mfma_f32_16x16x32_bf16(af, b8, accf[nt], 0, 0, 0);
            accb[nt] = __builtin_amdgcn_mfma_f32_16x16x32_bf16(ab8, b8, accb[nt], 0, 0, 0); }
    }
    LAS unsigned char* ot = F.lds + L_TC;
#pragma unroll
    for (int nt = 0; nt < 4; ++nt)
#pragma unroll
        for (int rg = 0; rg < 4; ++rg) { const int p = p0 + 4 * lg + rg, n = nh * 64 + 16 * nt + (lane & 15);
            *(LAS bf16*)(ot + p * TS + n * 2) = (bf16)f2bf(accf[nt][rg]);
            *(LAS bf16*)(ot + (64 + p) * TS + n * 2) = (bf16)f2bf(accb[nt][rg]); }
    __syncthreads();
    bf16* SE = (bf16*)(F.ws_() + WS_SEND);
#pragma unroll
    for (int i = 0; i < 4; ++i) { const int q = tid + 512 * i, d = q >> 10, p = (q & 1023) >> 4, ch = q & 15;
        *(GAS v4u*)(SE + ((size_t)(c * 64 + d * 32 + h) * 64 + p) * 128 + ch * 8) = *(const LAS v4u*)(ot + (d * 64 + p) * TS + ch * 16); }
}

__device__ __forceinline__ void ssd_chunk_scan_phase(Frame& F) {
    const int tid = opaque_tid();
    const bf16* SE = (const bf16*)(F.ws_() + WS_SEND); const float* CHD = (const float*)(F.ws_() + WS_CHD); bf16* HIN = (bf16*)(F.ws_() + WS_HIN);
    for (int e = blockIdx.x * 512 + tid; e < 64 * 64 * 32; e += F.G * 512) {
        const int dh = e >> 11, rem = e & 2047, d = dh >> 5;
        f32x4 hst = (f32x4){0.f, 0.f, 0.f, 0.f};
#pragma unroll 1
        for (int s0 = 0; s0 < NCHUNK; s0 += 10) {
            f32x4 sv[10]; float dec[10]; int cc[10];
#pragma unroll
            for (int k = 0; k < 10; ++k) { cc[k] = chunk_order(d, s0 + k); { const v2u w = *(const GAS v2u*)(SE + ((size_t)(cc[k] * 64 + dh) * 2048 + rem) * 4); sv[k] = (f32x4){bflo(w.x), bfhi(w.x), bflo(w.y), bfhi(w.y)}; } dec[k] = CHD[cc[k] * 64 + dh]; }
#pragma unroll
            for (int k = 0; k < 10; ++k) { v2u o; o.x = pk2(hst.x, hst.y); o.y = pk2(hst.z, hst.w);
                *(GAS v2u*)(HIN + ((size_t)(cc[k] * 64 + dh) * 2048 + rem) * 4) = o;
                hst = dec[k] * hst + sv[k]; }
        }
    }
}

__device__ __forceinline__ void ssd_out_compute(Frame& F, int l, int c, int h, int tid, int lane, int wave) {
    const int r0 = c * 128;
    LAS float* cs = (LAS float*)(F.lds + L_CS);
    const int i0 = 16 * wave, lg = lane >> 4, lc = lane & 15, q4 = lc >> 2, pp = lane & 3;
    const unsigned ldsb = (unsigned)(size_t)F.lds;
    bf16x8v cfr[4];
#pragma unroll
    for (int ks = 0; ks < 4; ++ks) cfr[ks] = *(const LAS bf16x8v*)(F.lds + L_TC + (i0 + lc) * TS + (32 * ks + 8 * lg) * 2);
    f32x4 cb[8];
#pragma unroll
    for (int jt = 0; jt < 8; ++jt) { cb[jt] = (f32x4){0.f, 0.f, 0.f, 0.f};
#pragma unroll
        for (int ks = 0; ks < 4; ++ks) { const bf16x8v bfr = *(const LAS bf16x8v*)(F.lds + L_TB + (16 * jt + lc) * TS + (32 * ks + 8 * lg) * 2);
            cb[jt] = __builtin_amdgcn_mfma_f32_16x16x32_bf16(cfr[ks], bfr, cb[jt], 0, 0, 0); }
        if (jt & 1) asm volatile("" ::: "memory"); }
    f32x4 yof[4], yob[4], yd[4];
#pragma unroll
    for (int pt = 0; pt < 4; ++pt) { yof[pt] = (f32x4){0.f, 0.f, 0.f, 0.f}; yob[pt] = (f32x4){0.f, 0.f, 0.f, 0.f}; yd[pt] = (f32x4){0.f, 0.f, 0.f, 0.f};
#pragma unroll
        for (int ks = 0; ks < 4; ++ks) {
            const bf16x8v hf = *(const LAS bf16x8v*)(F.lds + L_HF + (16 * pt + lc) * TS + (32 * ks + 8 * lg) * 2);
            const bf16x8v hb = *(const LAS bf16x8v*)(F.lds + L_HB + (16 * pt + lc) * TS + (32 * ks + 8 * lg) * 2);
            yof[pt] = __builtin_amdgcn_mfma_f32_16x16x32_bf16(cfr[ks], hf, yof[pt], 0, 0, 0);
            yob[pt] = __builtin_amdgcn_mfma_f32_16x16x32_bf16(cfr[ks], hb, yob[pt], 0, 0, 0); }
        asm volatile("" ::: "memory"); }
    __syncthreads();
    float csi_f[4], csi_b[4];
#pragma unroll
    for (int rg = 0; rg < 4; ++rg) { csi_f[rg] = cs[i0 + 4 * lg + rg]; csi_b[rg] = cs[128 + i0 + 4 * lg + rg]; }
#pragma unroll
    for (int d = 0; d < 2; ++d) {
        const int kslo = d == 0 ? 0 : (wave >> 1), kshi = d == 0 ? (wave >> 1) : 3;
#pragma unroll
        for (int jt = 0; jt < 8; ++jt) {
            if ((jt >> 1) < kslo || (jt >> 1) > kshi) continue;
            const int j = 16 * jt + lc;
            if (d == 0 ? (jt <= wave) : (jt >= wave)) {
                const float kj = cs[d * 128 + j];
#pragma unroll
                for (int rg = 0; rg < 4; ++rg) { const int i = i0 + 4 * lg + rg; const bool ok = d == 0 ? (j <= i) : (j >= i);
                    const float ki = d == 0 ? csi_f[rg] : csi_b[rg];
                    const float m = ok ? cb[jt][rg] * __expf(ki - kj) : 0.f;
                    *(LAS bf16*)(F.lds + L_TB + i * TS + j * 2) = (bf16)f2bf(m); }
            } else {
#pragma unroll
                for (int rg = 0; rg < 4; ++rg) *(LAS bf16*)(F.lds + L_TB + (i0 + 4 * lg + rg) * TS + j * 2) = (bf16)0;
            }
        }
        LDS_WAIT(); asm volatile("" ::: "memory");
#pragma unroll
        for (int ks = 0; ks < 4; ++ks) {
            if (ks < kslo || ks > kshi) continue;
            const bf16x8v mfr = *(const LAS bf16x8v*)(F.lds + L_TB + (i0 + lc) * TS + (32 * ks + 8 * lg) * 2);
            const unsigned ax = ldsb + (unsigned)((d ? L_XB : L_XF) + (32 * ks + 8 * lg + q4) * XS + 4 * pp * 2);
            bf16x4v xl[4], xh[4];
#pragma unroll
            for (int pt = 0; pt < 4; ++pt) { xl[pt] = ds_tr16(ax + 32 * pt); xh[pt] = ds_tr16(ax + 32 * pt + 4 * XS); }
            TR_WAIT4(xl[0], xh[0], xl[1], xh[1]); TR_WAIT4(xl[2], xh[2], xl[3], xh[3]);
#pragma unroll
            for (int pt = 0; pt < 4; ++pt) yd[pt] = __builtin_amdgcn_mfma_f32_16x16x32_bf16(mfr, cat8(xl[pt], xh[pt]), yd[pt], 0, 0, 0);
        }
        LDS_WAIT(); asm volatile("" ::: "memory");
    }
    const float dsk = F.in_(I_SD)[l * 32 + h];
    LAS unsigned char* yt = F.lds + L_TC;
#pragma unroll
    for (int rg = 0; rg < 4; ++rg) { const int i = i0 + 4 * lg + rg; const float ef = cs[2 * 128 + i], eb = cs[3 * 128 + i], rdt = __builtin_amdgcn_rcpf(cs[4 * 128 + i]);
#pragma unroll
        for (int pt = 0; pt < 4; ++pt) { const int p = 16 * pt + lc;
            const float xr = bf2f(*(const LAS bf16*)(F.lds + L_XF + i * XS + p * 2)) * rdt;
            *(LAS bf16*)(yt + i * XS + p * 2) = (bf16)f2bf(yd[pt][rg] + ef * yof[pt][rg] + eb * yob[pt][rg] + dsk * xr); } }
    __syncthreads();
    bf16* Y = (bf16*)(F.ws_() + WS_Y);
#pragma unroll
    for (int i2 = 0; i2 < 2; ++i2) { const int q = tid + 512 * i2, row = q >> 3, ch = q & 7;
        *(GAS v4u*)(Y + (size_t)(r0 + row) * SSD_DI + h * 64 + ch * 8) = *(const LAS v4u*)(yt + row * XS + ch * 16); }
}

__device__ __forceinline__ void ssd_states_loop(Frame& F, int tid, int lane, int wave) {
    LAS float* cs = (LAS float*)(F.lds + L_CS);
    SsdPre p; int u = vwg(F.G);
    if (u < NCHUNK * 32) ssd_fetch<false>(F, p, u >> 5, u & 31, tid, lane, wave);
#pragma unroll 1
    for (; u < NCHUNK * 32; u += F.G) {
        const int c = u >> 5, h = u & 31;
        __syncthreads();
        ssd_stage_cs<true>(F, p, c, h, lane, wave);
        ssd_commit_tiles<false>(F, p, tid);
        __syncthreads();
        ssd_commit_x(F, p, cs + 2 * 128, cs + 3 * 128, tid);
        if (u + F.G < NCHUNK * 32) ssd_fetch<false>(F, p, (u + F.G) >> 5, (u + F.G) & 31, tid, lane, wave);
        __syncthreads();
        ssd_states_compute(F, c, h, tid, lane, wave);
    }
}
__device__ __forceinline__ void ssd_out_loop(Frame& F, int l, int tid, int lane, int wave) {
    LAS float* cs = (LAS float*)(F.lds + L_CS);
    SsdPre p; int u = vwg(F.G);
    if (u < NCHUNK * 32) ssd_fetch<true>(F, p, u >> 5, u & 31, tid, lane, wave);
#pragma unroll 1
    for (; u < NCHUNK * 32; u += F.G) {
        const int c = u >> 5, h = u & 31;
        __syncthreads();
        ssd_fetch_h(F, p, c, h, tid);
        ssd_stage_cs<false>(F, p, c, h, lane, wave);
        ssd_commit_tiles<true>(F, p, tid);
        __syncthreads();
        ssd_commit_x(F, p, cs + 4 * 128, cs + 5 * 128, tid);
        ssd_commit_h(F, p, tid);
        if (u + F.G < NCHUNK * 32) ssd_fetch<true>(F, p, (u + F.G) >> 5, (u + F.G) & 31, tid, lane, wave);
        __syncthreads();
        ssd_out_compute(F, l, c, h, tid, lane, wave);
    }
}

constexpr int NA_VS = 272, NA_VTILE = 32 * NA_VS, NA_VBUF = NA_VTILE + 1920;
__device__ __forceinline__ void na_unit(Frame& F, int l, int qb, int h, LAS unsigned char* vbuf, int lane) {
    const int lc = lane & 15, lg = lane >> 4, q4 = lc >> 2, pp = lane & 3;
    const bf16* QN = (const bf16*)(F.ws_() + WS_QN); const bf16* KN = (const bf16*)(F.ws_() + WS_KN); const bf16* P = (const bf16*)(F.ws_() + WS_P);
    bf16* MIX = (bf16*)(F.ws_() + WS_MIX);
    const bool isc = qb < 16; const int rq0 = qb * 16;
    const int t0 = rq0 - CTX, qr = t0 >> 6, b = (t0 & 63) >> 4;
    const int kc0 = b == 0 ? 0 : (b == 1 ? 8 : (b == 2 ? 24 : 32));
    const int band0 = min(max(qr - 4, 0), 256 - 8);
    const int qc = 16 * b + lc, c0q = min(max(qc - 8, 0), GRID_W - 16);
    const float scale = 0.08838834764831845f;
    const float M = ((const float*)(F.ws_() + WS_NAB))[l * 8 + h];
    LAS float* rtab = (LAS float*)(vbuf + NA_VTILE);
    if (!isc) { const float* rpb = F.in_(I_RPB) + (size_t)(l * 8 + h) * 15 * 31;
#pragma unroll
        for (int i = 0; i < 8; ++i) { const int idx = lane + 64 * i; if (idx < 465) rtab[idx] = rpb[idx]; } }
    bf16x8v qf[4];
#pragma unroll
    for (int ks = 0; ks < 4; ++ks) qf[ks] = *(const GAS bf16x8v*)(QN + (size_t)(rq0 + lc) * 1024 + h * 128 + 32 * ks + 8 * lg);
    f32x4 o[8];
#pragma unroll
    for (int dt = 0; dt < 8; ++dt) o[dt] = (f32x4){0.f, 0.f, 0.f, 0.f};
    float lsum = 0.f;
    const unsigned vb = (unsigned)(size_t)vbuf;
    const int nblk = isc ? 8 : 16;
#define NA_KROW0(blk) ((!isc && (blk) < 8) ? CTX + (band0 + (blk)) * GRID_W + kc0 : (isc ? (blk) : (blk) - 8) * 32)
#define NA_LOADK(blk) do { const int kr0_ = NA_KROW0(blk); \
        _Pragma("unroll") for (int t = 0; t < 2; ++t) _Pragma("unroll") for (int ks = 0; ks < 4; ++ks) kf[t][ks] = *(const GAS bf16x8v*)(KN + (size_t)(kr0_ + 16 * t + lc) * 1024 + h * 128 + 32 * ks + 8 * lg); } while (0)
#define NA_LOADV(blk) do { const int kr0_ = NA_KROW0(blk); \
        _Pragma("unroll") for (int i = 0; i < 8; ++i) { const int idx = lane + 64 * i, row = idx >> 4, ch = idx & 15; vr[i] = *(const GAS v4u*)(P + (size_t)(kr0_ + row) * NIN + OFF_V + h * 128 + ch * 8); } } while (0)
    bf16x8v kf[2][4]; v4u vr[8];
    NA_LOADK(0); NA_LOADV(0);
#pragma unroll 1
    for (int blk = 0; blk < nblk; ++blk) {
        const bool local = !isc && blk < 8; const int nb = (blk + 1 < nblk) ? blk + 1 : blk;
        f32x4 st[2];
#pragma unroll
        for (int t = 0; t < 2; ++t) { st[t] = (f32x4){0.f, 0.f, 0.f, 0.f};
#pragma unroll
            for (int ks = 0; ks < 4; ++ks) st[t] = __builtin_amdgcn_mfma_f32_16x16x32_bf16(kf[t][ks], qf[ks], st[t], 0, 0, 0); }
        NA_LOADK(nb);
#pragma unroll
        for (int i = 0; i < 8; ++i) { const int idx = lane + 64 * i, row = idx >> 4, ch = idx & 15; *(LAS v4u*)(vbuf + row * NA_VS + ch * 16) = vr[i]; }
        NA_LOADV(nb);
        float p[2][4];
#pragma unroll
        for (int t = 0; t < 2; ++t)
#pragma unroll
            for (int rg = 0; rg < 4; ++rg) {
                float sv = st[t][rg] * scale;
                if (local) { const int kc = kc0 + 16 * t + 4 * lg + rg; const bool ok = (kc >= c0q) && (kc < c0q + 16);
                    const int bi = min(max(kc - qc + 15, 0), 30);
                    const float bias = rtab[(band0 + blk - qr + 7) * 31 + bi];
                    sv = ok ? sv + bias : -INFINITY; }
                const float e = __expf(sv - M); p[t][rg] = e; lsum += e; }
        bf16x8v pf; { v4u w; w.x = pk2(p[0][0], p[0][1]); w.y = pk2(p[0][2], p[0][3]); w.z = pk2(p[1][0], p[1][1]); w.w = pk2(p[1][2], p[1][3]); pf = __builtin_bit_cast(bf16x8v, w); }
        LDS_WAIT(); asm volatile("" ::: "memory");
#pragma unroll
        for (int dh = 0; dh < 2; ++dh) {
            bf16x4v vl[4], vh[4];
#pragma unroll
            for (int k = 0; k < 4; ++k) { const unsigned a = vb + (unsigned)((4 * lg + q4) * NA_VS + (16 * (4 * dh + k) + 4 * pp) * 2); vl[k] = ds_tr16(a); vh[k] = ds_tr16(a + 16 * NA_VS); }
            TR_WAIT4(vl[0], vh[0], vl[1], vh[1]); TR_WAIT4(vl[2], vh[2], vl[3], vh[3]);
#pragma unroll
            for (int k = 0; k < 4; ++k) o[4 * dh + k] = __builtin_amdgcn_mfma_f32_16x16x32_bf16(cat8(vl[k], vh[k]), pf, o[4 * dh + k], 0, 0, 0);
        }
    }
#undef NA_LOADK
#undef NA_LOADV
#undef NA_KROW0
    lsum += __shfl_xor(lsum, 16); lsum += __shfl_xor(lsum, 32);
    const float inv = 1.f / lsum;
    bf16* orow = MIX + (size_t)(rq0 + lc) * D + 2048 + h * 128 + 4 * lg;
#pragma unroll
    for (int dt = 0; dt < 8; ++dt) { v2u w; w.x = pk2(o[dt][0] * inv, o[dt][1] * inv); w.y = pk2(o[dt][2] * inv, o[dt][3] * inv); *(GAS v2u*)(orow + 16 * dt) = w; }
}
constexpr int NAW_TILE = 64 * NA_VS, NAW_BUF = 2 * NAW_TILE, NAW_RTAB = 2 * NAW_BUF;
__device__ __forceinline__ void na_span(const LAS unsigned char* kt, unsigned vt_addr, int k0, bool local, int kcol0, int brow, int qc, int c0q, const LAS float* rtab, float M,
                                        const bf16x8v (&qf)[4], f32x4 (&o)[8], float& lsum, int lc, int lg, int q4, int pp) {
    const float scale = 0.08838834764831845f;
    f32x4 st[2];
#pragma unroll
    for (int t = 0; t < 2; ++t) { st[t] = (f32x4){0.f, 0.f, 0.f, 0.f};
#pragma unroll
        for (int ks = 0; ks < 4; ++ks) { const bf16x8v kf = *(const LAS bf16x8v*)(kt + (k0 + 16 * t + lc) * NA_VS + (32 * ks + 8 * lg) * 2);
            st[t] = __builtin_amdgcn_mfma_f32_16x16x32_bf16(kf, qf[ks], st[t], 0, 0, 0); } }
    float p[2][4];
#pragma unroll
    for (int t = 0; t < 2; ++t)
#pragma unroll
        for (int rg = 0; rg < 4; ++rg) {
            float sv = st[t][rg] * scale;
            if (local) { const int kc = kcol0 + 16 * t + 4 * lg + rg; const bool ok = (kc >= c0q) && (kc < c0q + 16);
                const int bi = min(max(kc - qc + 15, 0), 30);
                const float bias = rtab[brow * 31 + bi];
                sv = ok ? sv + bias : -INFINITY; }
            const float e = __expf(sv - M); p[t][rg] = e; lsum += e; }
    bf16x8v pf; { v4u w; w.x = pk2(p[0][0], p[0][1]); w.y = pk2(p[0][2], p[0][3]); w.z = pk2(p[1][0], p[1][1]); w.w = pk2(p[1][2], p[1][3]); pf = __builtin_bit_cast(bf16x8v, w); }
#pragma unroll
    for (int dh = 0; dh < 2; ++dh) {
        bf16x4v vl[4], vh[4];
#pragma unroll
        for (int k = 0; k < 4; ++k) { const unsigned a = vt_addr + (unsigned)((k0 + 4 * lg + q4) * NA_VS + (16 * (4 * dh + k) + 4 * pp) * 2); vl[k] = ds_tr16(a); vh[k] = ds_tr16(a + 16 * NA_VS); }
        TR_WAIT4(vl[0], vh[0], vl[1], vh[1]); TR_WAIT4(vl[2], vh[2], vl[3], vh[3]);
#pragma unroll
        for (int k = 0; k < 4; ++k) o[4 * dh + k] = __builtin_amdgcn_mfma_f32_16x16x32_bf16(cat8(vl[k], vh[k]), pf, o[4 * dh + k], 0, 0, 0);
    }
}
__device__ __forceinline__ void na_wg_unit(Frame& F, int l, int rgp, int h, int tid, int lane, int wave) {
    const int lc = lane & 15, lg = lane >> 4, q4 = lc >> 2, pp = lane & 3;
    const bf16* QN = (const bf16*)(F.ws_() + WS_QN); const bf16* KN = (const bf16*)(F.ws_() + WS_KN); const bf16* P = (const bf16*)(F.ws_() + WS_P);
    bf16* MIX = (bf16*)(F.ws_() + WS_MIX);
    const int qr = 4 * rgp + (wave >> 1), bsel = 2 * (wave & 1);
    const int band0 = min(max(qr - 4, 0), 256 - 8);
    const int U0 = min(max(4 * rgp - 4, 0), 256 - 8), U1 = min(max(4 * rgp - 1, 0), 256 - 8) + 7, nrows = U1 - U0 + 1, NI = nrows + 4;
    const float M = ((const float*)(F.ws_() + WS_NAB))[l * 8 + h];
    LAS float* rtab = (LAS float*)(F.lds + RING_OFF + NAW_RTAB);
    __syncthreads();
    { const float* rpb = F.in_(I_RPB) + (size_t)(l * 8 + h) * 15 * 31; if (tid < 465) rtab[tid] = rpb[tid]; }
    bf16x8v qf[2][4]; f32x4 o[2][8]; float lsum[2] = {0.f, 0.f};
#pragma unroll
    for (int qb = 0; qb < 2; ++qb) { const int rq0 = CTX + qr * GRID_W + 16 * (bsel + qb);
#pragma unroll
        for (int ks = 0; ks < 4; ++ks) qf[qb][ks] = *(const GAS bf16x8v*)(QN + (size_t)(rq0 + lc) * 1024 + h * 128 + 32 * ks + 8 * lg);
#pragma unroll
        for (int dt = 0; dt < 8; ++dt) o[qb][dt] = (f32x4){0.f, 0.f, 0.f, 0.f}; }
    v4u kq[2], vq[2];
#define NAW_LOAD(it) do { const int base_ = (it) < nrows ? CTX + (U0 + (it)) * GRID_W : ((it) - nrows) * 64; \
        _Pragma("unroll") for (int i = 0; i < 2; ++i) { const int q = tid + 512 * i, key = q >> 4, ch = q & 15; \
            kq[i] = *(const GAS v4u*)(KN + (size_t)(base_ + key) * 1024 + h * 128 + ch * 8); vq[i] = *(const GAS v4u*)(P + (size_t)(base_ + key) * NIN + OFF_V + h * 128 + ch * 8); } } while (0)
    NAW_LOAD(0);
#pragma unroll 1
    for (int it = 0; it < NI; ++it) {
        LAS unsigned char* buf = F.lds + RING_OFF + (it & 1) * NAW_BUF;
#pragma unroll
        for (int i = 0; i < 2; ++i) { const int q = tid + 512 * i, key = q >> 4, ch = q & 15; *(LAS v4u*)(buf + key * NA_VS + ch * 16) = kq[i]; *(LAS v4u*)(buf + NAW_TILE + key * NA_VS + ch * 16) = vq[i]; }
        if (it + 1 < NI) NAW_LOAD(it + 1);
        __syncthreads();
        const bool local = it < nrows; const int kr = U0 + it;
        if (local && (kr < band0 || kr >= band0 + 8)) continue;
        const unsigned vt_addr = (unsigned)(size_t)(buf + NAW_TILE);
#pragma unroll
        for (int qb = 0; qb < 2; ++qb) { const int b = bsel + qb, qc = 16 * b + lc, c0q = min(max(qc - 8, 0), GRID_W - 16);
            const int kc0 = b == 0 ? 0 : (b == 1 ? 8 : (b == 2 ? 24 : 32));
            if (local) na_span(buf, vt_addr, kc0, true, kc0, kr - qr + 7, qc, c0q, rtab, M, qf[qb], o[qb], lsum[qb], lc, lg, q4, pp);
            else { na_span(buf, vt_addr, 0, false, 0, 0, qc, c0q, rtab, M, qf[qb], o[qb], lsum[qb], lc, lg, q4, pp);
                   na_span(buf, vt_addr, 32, false, 0, 0, qc, c0q, rtab, M, qf[qb], o[qb], lsum[qb], lc, lg, q4, pp); } }
    }
#undef NAW_LOAD
#pragma unroll
    for (int qb = 0; qb < 2; ++qb) { float ls = lsum[qb]; ls += __shfl_xor(ls, 16); ls += __shfl_xor(ls, 32); const float inv = 1.f / ls;
        bf16* orow = MIX + (size_t)(CTX + qr * GRID_W + 16 * (bsel + qb) + lc) * D + 2048 + h * 128 + 4 * lg;
#pragma unroll
        for (int dt = 0; dt < 8; ++dt) { v2u w; w.x = pk2(o[qb][dt][0] * inv, o[qb][dt][1] * inv); w.y = pk2(o[qb][dt][2] * inv, o[qb][dt][3] * inv); *(GAS v2u*)(orow + 16 * dt) = w; } }
}

__device__ __forceinline__ void pool_mm_unit(Frame& F, int l, int u, int lane) {
    const int lc = lane & 15, lg = lane >> 4;
    const int rb = u >> 4, g = (u >> 2) & 3, dq = u & 3, r0 = rb * 16;
    const bf16* PL = (const bf16*)(F.ws_() + WS_PL); bf16* MIX = (bf16*)(F.ws_() + WS_MIX);
    const bf16* WT = (const bf16*)(F.ws_() + WS_WPOOL) + (size_t)(l * 4 + g) * 65536;
    f32x4 acc[4];
#pragma unroll
    for (int nt = 0; nt < 4; ++nt) acc[nt] = (f32x4){0.f, 0.f, 0.f, 0.f};
#pragma unroll
    for (int ks = 0; ks < 8; ++ks) {
        const bf16x8v pf = *(const GAS bf16x8v*)(PL + (size_t)(r0 + lc) * 1024 + g * 256 + 32 * ks + 8 * lg);
#pragma unroll
        for (int nt = 0; nt < 4; ++nt) { const bf16x8v wf = *(const GAS bf16x8v*)(WT + (size_t)(dq * 64 + 16 * nt + lc) * 256 + 32 * ks + 8 * lg);
            acc[nt] = __builtin_amdgcn_mfma_f32_16x16x32_bf16(wf, pf, acc[nt], 0, 0, 0); }
    }
    const float* ps = F.in_(I_PS) + l * 1024 + g * 256 + dq * 64 + 4 * lg;
    bf16* orow = MIX + (size_t)(r0 + lc) * D + 3072 + g * 256 + dq * 64 + 4 * lg;
#pragma unroll
    for (int nt = 0; nt < 4; ++nt) { const f32x4 sc = *(const GAS f32x4*)(ps + 16 * nt);
        v2u w; w.x = pk2(acc[nt][0] * sc.x, acc[nt][1] * sc.y); w.y = pk2(acc[nt][2] * sc.z, acc[nt][3] * sc.w); *(GAS v2u*)(orow + 16 * nt) = w; }
}

constexpr int PW_S = 528;
__device__ __forceinline__ void pool_mm_wg(Frame& F, int l, int rb0, int tid, int lane, int wave) {
    const int lc = lane & 15, lg = lane >> 4;
    const int g = (int)blockIdx.x & 3, jwg = (int)blockIdx.x >> 2, nwg = F.G >> 2;
    const bf16* PL = (const bf16*)(F.ws_() + WS_PL); bf16* MIX = (bf16*)(F.ws_() + WS_MIX);
    const bf16* WT = (const bf16*)(F.ws_() + WS_WPOOL) + (size_t)(l * 4 + g) * 65536;
    __syncthreads();
#pragma unroll 4
    for (int i = 0; i < 16; ++i) { const int q = tid + 512 * i, row = q >> 5, ch = q & 31;
        *(LAS v4u*)(F.lds + RING_OFF + row * PW_S + ch * 16) = *(const GAS v4u*)(WT + (size_t)row * 256 + ch * 8); }
    __syncthreads();
    const float* ps = F.in_(I_PS) + l * 1024 + g * 256 + 4 * lg;
#pragma unroll 1
    for (int rb = rb0 + jwg * NWAVES + wave; rb < R / 16; rb += nwg * NWAVES) {
        const int r0 = rb * 16;
        f32x4 acc[16];
#pragma unroll
        for (int nt = 0; nt < 16; ++nt) acc[nt] = (f32x4){0.f, 0.f, 0.f, 0.f};
        bf16x8v pf[8];
#pragma unroll
        for (int ks = 0; ks < 8; ++ks) pf[ks] = *(const GAS bf16x8v*)(PL + (size_t)(r0 + lc) * 1024 + g * 256 + 32 * ks + 8 * lg);
#pragma unroll
        for (int ks = 0; ks < 8; ++ks) {
#pragma unroll
            for (int nt = 0; nt < 16; ++nt) { const bf16x8v wf = *(const LAS bf16x8v*)(F.lds + RING_OFF + (16 * nt + lc) * PW_S + (32 * ks + 8 * lg) * 2);
                acc[nt] = __builtin_amdgcn_mfma_f32_16x16x32_bf16(wf, pf[ks], acc[nt], 0, 0, 0);
                if ((nt & 7) == 7) asm volatile("" ::: "memory"); } }
        bf16* orow = MIX + (size_t)(r0 + lc) * D + 3072 + g * 256 + 4 * lg;
#pragma unroll
        for (int nt = 0; nt < 16; ++nt) { const f32x4 sc = *(const GAS f32x4*)(ps + 16 * nt);
            v2u w; w.x = pk2(acc[nt][0] * sc.x, acc[nt][1] * sc.y); w.y = pk2(acc[nt][2] * sc.z, acc[nt][3] * sc.w); *(GAS v2u*)(orow + 16 * nt) = w; }
    }
    __syncthreads();
}

__device__ __forceinline__ void ssd_gate_phase(Frame& F, int l) {
    const int tid = opaque_tid(), lane = tid & 63, wave = __builtin_amdgcn_readfirstlane(tid >> 6); (void)lane; (void)wave;
    const int gw = blockIdx.x * NWAVES + wave, NGW = F.G * NWAVES;
    const bf16* P = (const bf16*)(F.ws_() + WS_P);
    const bf16* Y0 = (const bf16*)(F.ws_() + WS_Y);
    bf16* MIX = (bf16*)(F.ws_() + WS_MIX);
    const float* nw = F.in_(I_SNW) + (size_t)l * SSD_DI;
    for (int r = gw; r < R; r += NGW) {
        float v[4][8]; float ss = 0.f;
#pragma unroll
        for (int it = 0; it < 4; ++it) {
            const int ch = it * 512 + lane * 8;
            const v4u zv = *(const GAS v4u*)(P + (size_t)r * NIN + OFF_Z + ch);
            const v4u yv = *(const GAS v4u*)(Y0 + (size_t)r * SSD_DI + ch);
            const float zf[8] = {bflo(zv.x), bfhi(zv.x), bflo(zv.y), bfhi(zv.y), bflo(zv.z), bfhi(zv.z), bflo(zv.w), bfhi(zv.w)};
            const float yf[8] = {bflo(yv.x), bfhi(yv.x), bflo(yv.y), bfhi(yv.y), bflo(yv.z), bfhi(yv.z), bflo(yv.w), bfhi(yv.w)};
#pragma unroll
            for (int e = 0; e < 8; ++e) { const float q = yf[e] * silu_f(zf[e]); v[it][e] = q; ss += q * q; }
        }
        const float rstd = rsqrtf(wave_sum(ss) * (1.f / SSD_DI) + RMS_EPS);
#pragma unroll
        for (int it = 0; it < 4; ++it) { const int ch = it * 512 + lane * 8;
            const f32x4 w0 = *(const GAS f32x4*)(nw + ch), w1 = *(const GAS f32x4*)(nw + ch + 4);
            v4u o; o.x = pk2(v[it][0] * rstd * w0.x, v[it][1] * rstd * w0.y); o.y = pk2(v[it][2] * rstd * w0.z, v[it][3] * rstd * w0.w);
            o.z = pk2(v[it][4] * rstd * w1.x, v[it][5] * rstd * w1.y); o.w = pk2(v[it][6] * rstd * w1.z, v[it][7] * rstd * w1.w);
            *(GAS v4u*)(MIX + (size_t)r * D + ch) = o; }
    }
}

__device__ __forceinline__ void ffn_edge_phase(Frame& F, int l) {
    const int tid = opaque_tid();
    const bf16* E = (const bf16*)(F.ws_() + WS_E); bf16* ACT = (bf16*)(F.ws_() + WS_ACT);
    const float* cw = F.in_(I_MCW) + (size_t)l * 3 * DFF2; const float* cb = F.in_(I_MCB) + (size_t)l * DFF2;
    constexpr int NCH4 = DFF / 4, NBLK = R / 64;
    for (int i = blockIdx.x * 512 + tid; i < NBLK * 2 * NCH4; i += F.G * 512) {
        const int c4 = i % NCH4, bs = i / NCH4, sd = bs & 1, blk = bs >> 1, j = c4 * 4;
        const int col = 256 * (j >> 7) + (j & 127);
        const bf16* ec = E + (size_t)blk * 4 * DFF2 + col;
#define ELD(p) ({ const v2u w_ = *(const GAS v2u*)(p); (f32x4){bflo(w_.x), bfhi(w_.x), bflo(w_.y), bfhi(w_.y)}; })
        const f32x4 z = (f32x4){0.f, 0.f, 0.f, 0.f};
        f32x4 gp, gc, gn, vp, vc, vn;
        if (sd == 0) { const bool has = (blk > 0) && (blk != CTX / 64);
            gp = has ? ELD(ec - DFF2) : z; vp = has ? ELD(ec - DFF2 + 128) : z;
            gc = ELD(ec); vc = ELD(ec + 128); gn = ELD(ec + DFF2); vn = ELD(ec + DFF2 + 128); }
        else { const bool has = (blk < NBLK - 1) && (blk != CTX / 64 - 1);
            gp = ELD(ec + 2 * DFF2); vp = ELD(ec + 2 * DFF2 + 128); gc = ELD(ec + 3 * DFF2); vc = ELD(ec + 3 * DFF2 + 128);
            gn = has ? ELD(ec + 4 * DFF2) : z; vn = has ? ELD(ec + 4 * DFF2 + 128) : z; }
        const f32x4 g0 = *(const GAS f32x4*)(cw + j), g1 = *(const GAS f32x4*)(cw + DFF2 + j), g2 = *(const GAS f32x4*)(cw + 2 * DFF2 + j), gb = *(const GAS f32x4*)(cb + j);
        const f32x4 v0 = *(const GAS f32x4*)(cw + DFF + j), v1 = *(const GAS f32x4*)(cw + DFF2 + DFF + j), v2 = *(const GAS f32x4*)(cw + 2 * DFF2 + DFF + j), vb = *(const GAS f32x4*)(cb + DFF + j);
        const f32x4 G = gb + g0 * gp + g1 * gc + g2 * gn, V = vb + v0 * vp + v1 * vc + v2 * vn;
        v2u o; o.x = pk2(silu_f(G.x) * V.x, silu_f(G.y) * V.y); o.y = pk2(silu_f(G.z) * V.z, silu_f(G.w) * V.w);
        *(GAS v2u*)(ACT + (size_t)(blk * 64 + (sd ? 63 : 0)) * DFF + j) = o;
#undef ELD
    }
}

constexpr int NPH_PRE = 2, NPH_LAYER = 12, NPH = NPH_PRE + DEPTH * NPH_LAYER;
struct Args { const float* in[25]; float* out; unsigned char* ws; int ph_lo, ph_hi; };
__global__ void __launch_bounds__(NWAVES * 64, 2) hymba_fwd(Args args) {
    extern __shared__ __attribute__((aligned(16))) unsigned char lds[];
    Frame F;
    F.lds = (LAS unsigned char*)lds;
    F.MISC = (volatile LAS unsigned*)(F.lds + MISC_OFF);
    { const unsigned slot = (unsigned)__builtin_amdgcn_s_getreg((5 << 11) | 4) & 63u; *(LAS int*)(size_t)((unsigned)TIDTAB_OFF + slot * 256u + (threadIdx.x & 63u) * 4u) = (int)threadIdx.x; }
    const int tid = threadIdx.x;
    F.G = gridDim.x;
    F.ctl = (gu32*)(args.ws + WS_CTL);
    for (int u = tid; u < (LDS_BYTES - LDSCTL_OFF) / 4; u += NWAVES * 64) ((LAS unsigned*)(F.lds + LDSCTL_OFF))[u] = 0u;
    __syncthreads();
#if MK_ONE_LAUNCH
    XcdBarrier bar = xcd_barrier_post((unsigned*)(F.ctl + CW_BAR), F.MISC + 8);
#define GRID_BAR() xcd_barrier(bar)
#else
#define GRID_BAR() do {} while (0)
#endif
    const int lo = args.ph_lo, hi = args.ph_hi;
#define IN(k) (lo <= (k) && (k) < hi)
#define SEAM(k) do { if (IN(k) && IN((k) + 1)) GRID_BAR(); } while (0)

    if (IN(0)) { for (int rep = 0; rep < NREP(100); ++rep) { s0_prologue(F); __syncthreads(); } }
    SEAM(0);
    if (IN(1)) { for (int rep = 0; rep < NREP(101); ++rep) { s1_ada_finalize(F); __syncthreads(); } } SEAM(1);

    { constexpr int l = 0;
        const int pb = NPH_PRE + l * NPH_LAYER;
        const float* xin_c = (l == 0) ? F.in_(I_CTX) : (const float*)(F.ws_() + WS_X2);
        const float* xin_l = (l == 0) ? F.in_(I_X) : (const float*)(F.ws_() + WS_X2) + (size_t)CTX * D;
        float* X1 = (float*)(F.ws_() + WS_X1);
        if (IN(pb + 0)) for (int rep = 0; rep < NREP(0); ++rep) {
            if (l == 0) norm_mod_phase<false>(F, xin_c, xin_l, F.in_(I_N1W) + (size_t)l * D, l, 0, 1);
            else norm_mod_phase<true>(F, (const float*)(F.ws_() + WS_X1), xin_l, F.in_(I_N1W) + (size_t)l * D, l, 0, 1, (const float*)(F.ws_() + WS_SPK), modp(F, l - 1, 1, 5), (float*)(F.ws_() + WS_X2));
        } SEAM(pb + 0);
        if (IN(pb + 1)) {
            constexpr int NT_IN = (R / 256) * (NIN / 256);
            const int rounds = (NT_IN + F.G - 1) / F.G, Gin = (NT_IN + rounds - 1) / rounds;
            if ((int)blockIdx.x < Gin) {
                pg8::Gemm g{(const bf16*)(F.ws_() + WS_H), (const bf16*)(F.ws_() + WS_WIN + l * SZ_WIN), R, NIN, D, D, D}; pg8::StaticOrder S; S.init(R, NIN, Gin, (int)blockIdx.x);
                pg8::EpiBf16 E{(bf16*)(F.ws_() + WS_P), NIN};
                pg8::gemm_phase<pg8::EpiBf16, pg8::StaticOrder, true, true>(F.lds + RING_OFF, g, S, E, opaque_tid());
            }
            __syncthreads();
            spare_convert<l>(F);
        } SEAM(pb + 1);
        if (IN(pb + 2)) { for (int rep = 0; rep < NREP(2); ++rep) { prep_phase(F, l); __syncthreads(); } } SEAM(pb + 2);
        if (IN(pb + 3)) for (int rep = 0; rep < NREP(3); ++rep) {
            const int t3 = opaque_tid(), lane3 = t3 & 63, wave3 = __builtin_amdgcn_readfirstlane(t3 >> 6);
            ssd_states_loop(F, t3, lane3, wave3);
            __syncthreads();
            for (int u = vwg(F.G); u < 64 * 8; u += F.G) na_wg_unit(F, l, u & 63, u >> 6, t3, lane3, wave3);
            __syncthreads();
        } SEAM(pb + 3);
        if (IN(pb + 4)) for (int rep = 0; rep < NREP(4); ++rep) {
            ssd_chunk_scan_phase(F);
            const int t3 = opaque_tid(), lane3 = t3 & 63, wave3 = __builtin_amdgcn_readfirstlane(t3 >> 6);
            LAS unsigned char* vbuf = F.lds + RING_OFF + wave3 * NA_VBUF;
            if (l < DEPTH - 1) for (int u = (int)blockIdx.x * NWAVES + wave3; u < 16 * 8; u += F.G * NWAVES) na_unit(F, l, u & 15, u >> 4, vbuf, lane3);
            const int rb0 = (l < DEPTH - 1) ? 0 : CTX / 16;
            pool_mm_wg(F, l, rb0, t3, lane3, wave3);
            __syncthreads();
        } SEAM(pb + 4);
        if (IN(pb + 5)) for (int rep = 0; rep < NREP(5); ++rep) {
            const int t3 = opaque_tid(), lane3 = t3 & 63, wave3 = __builtin_amdgcn_readfirstlane(t3 >> 6);
            ssd_out_loop(F, l, t3, lane3, wave3);
            __syncthreads();
        } SEAM(pb + 5);
        if (IN(pb + 6)) { for (int rep = 0; rep < NREP(6); ++rep) { ssd_gate_phase(F, l); __syncthreads(); } } SEAM(pb + 6);
        if (IN(pb + 7)) {
            { pg8::Gemm g{(const bf16*)(F.ws_() + WS_MIX), (const bf16*)(F.ws_() + WS_WOUT + l * SZ_WOUT), R, D, D, D, D}; pg8::StaticOrder S; S.init(SEQ, D, F.G, (int)blockIdx.x, 1);
              pg8::EpiResT<(l > 0), true> E{xin_l, X1 + (size_t)CTX * D, modp(F, l, 0, 2), D};
              pg8::gemm_phase<pg8::EpiResT<(l > 0), true>, pg8::StaticOrder, true, true>(F.lds + RING_OFF, g, S, E, opaque_tid()); }
            if (l < DEPTH - 1 && blockIdx.x < 256) { const int pn = (int)blockIdx.x & 15, ks = (int)blockIdx.x >> 4;
              pg8::Gemm g{(const bf16*)(F.ws_() + WS_MIX) + ks * 256, (const bf16*)(F.ws_() + WS_WOUT + l * SZ_WOUT) + ks * 256, CTX, D, 256, D, D}; pg8::OneUnit S{{0, pn}};
              pg8::EpiPart E{(float*)(F.ws_() + WS_SPK) + (size_t)ks * CTX * D, D};
              pg8::gemm_phase<pg8::EpiPart, pg8::OneUnit, true, true>(F.lds + RING_OFF, g, S, E, opaque_tid()); }
        } SEAM(pb + 7);
        if (IN(pb + 8)) for (int rep = 0; rep < NREP(8); ++rep) {
            if (l < DEPTH - 1) norm_mod_phase<true>(F, xin_c, X1 + (size_t)CTX * D, F.in_(I_N2W) + (size_t)l * D, l, 3, 4, (const float*)(F.ws_() + WS_SPK), modp(F, l, 1, 2), X1);
            else norm_mod_phase<true>(F, X1, X1 + (size_t)CTX * D, F.in_(I_N2W) + (size_t)l * D, l, 3, 4, nullptr, nullptr, nullptr, CTX);
        } SEAM(pb + 8);
        if (IN(pb + 9)) {
            pg8::Gemm g{(const bf16*)(F.ws_() + WS_H), (const bf16*)(F.ws_() + WS_WUP + l * SZ_WUP), R, DFF2, D, D, D}; pg8::StaticOrder S; S.init(l == DEPTH - 1 ? SEQ : R, DFF2, F.G, (int)blockIdx.x, l == DEPTH - 1 ? 1 : 0);
            pg8::EpiFFN E{(bf16*)(F.ws_() + WS_ACT), F.in_(I_MCW) + (size_t)l * 3 * DFF2, F.in_(I_MCB) + (size_t)l * DFF2, (pg8::bf16_t*)(F.ws_() + WS_E), DFF};
            pg8::gemm_phase<pg8::EpiFFN, pg8::StaticOrder, true, true>(F.lds + RING_OFF, g, S, E, opaque_tid());
        } SEAM(pb + 9);
        if (IN(pb + 10)) { for (int rep = 0; rep < NREP(10); ++rep) { ffn_edge_phase(F, l); __syncthreads(); } } SEAM(pb + 10);
        if (IN(pb + 11)) {
            { pg8::Gemm g{(const bf16*)(F.ws_() + WS_ACT), (const bf16*)(F.ws_() + WS_WDN + l * SZ_WDN), R, D, DFF, DFF, DFF}; pg8::StaticOrder S; S.init(SEQ, D, F.G, (int)blockIdx.x, 1);
              float* X2 = (float*)(F.ws_() + WS_X2);
              pg8::EpiResT<true, (l < DEPTH - 1)> E{X1 + (size_t)CTX * D, (l == DEPTH - 1) ? F.out_() : X2 + (size_t)CTX * D, modp(F, l, 0, 5), D};
              pg8::gemm_phase<pg8::EpiResT<true, (l < DEPTH - 1)>, pg8::StaticOrder, true, true>(F.lds + RING_OFF, g, S, E, opaque_tid()); }
            if (l < DEPTH - 1 && blockIdx.x < 256) { const int pn = (int)blockIdx.x & 15, ks = (int)blockIdx.x >> 4;
              const int koff = ks < 6 ? ks * 768 : 4608 + (ks - 6) * 640, kn = ks < 6 ? 768 : 640;
              pg8::Gemm g{(const bf16*)(F.ws_() + WS_ACT) + koff, (const bf16*)(F.ws_() + WS_WDN + l * SZ_WDN) + koff, CTX, D, kn, DFF, DFF}; pg8::OneUnit S{{0, pn}};
              pg8::EpiPart E{(float*)(F.ws_() + WS_SPK) + (size_t)ks * CTX * D, D};
              pg8::gemm_phase<pg8::EpiPart, pg8::OneUnit, true, true>(F.lds + RING_OFF, g, S, E, opaque_tid()); }
        } SEAM(pb + 11);
    }
    { constexpr int l = 1;
        const int pb = NPH_PRE + l * NPH_LAYER;
        const float* xin_c = (l == 0) ? F.in_(I_CTX) : (const float*)(F.ws_() + WS_X2);
        const float* xin_l = (l == 0) ? F.in_(I_X) : (const float*)(F.ws_() + WS_X2) + (size_t)CTX * D;
        float* X1 = (float*)(F.ws_() + WS_X1);
        if (IN(pb + 0)) for (int rep = 0; rep < NREP(0); ++rep) {
            if (l == 0) norm_mod_phase<false>(F, xin_c, xin_l, F.in_(I_N1W) + (size_t)l * D, l, 0, 1);
            else norm_mod_phase<true>(F, (const float*)(F.ws_() + WS_X1), xin_l, F.in_(I_N1W) + (size_t)l * D, l, 0, 1, (const float*)(F.ws_() + WS_SPK), modp(F, l - 1, 1, 5), (float*)(F.ws_() + WS_X2));
        } SEAM(pb + 0);
        if (IN(pb + 1)) {
            constexpr int NT_IN = (R / 256) * (NIN / 256);
            const int rounds = (NT_IN + F.G - 1) / F.G, Gin = (NT_IN + rounds - 1) / rounds;
            if ((int)blockIdx.x < Gin) {
                pg8::Gemm g{(const bf16*)(F.ws_() + WS_H), (const bf16*)(F.ws_() + WS_WIN + l * SZ_WIN), R, NIN, D, D, D}; pg8::StaticOrder S; S.init(R, NIN, Gin, (int)blockIdx.x);
                pg8::EpiBf16 E{(bf16*)(F.ws_() + WS_P), NIN};
                pg8::gemm_phase<pg8::EpiBf16, pg8::StaticOrder, true, true>(F.lds + RING_OFF, g, S, E, opaque_tid());
            }
            __syncthreads();
            spare_convert<l>(F);
        } SEAM(pb + 1);
        if (IN(pb + 2)) { for (int rep = 0; rep < NREP(2); ++rep) { prep_phase(F, l); __syncthreads(); } } SEAM(pb + 2);
        if (IN(pb + 3)) for (int rep = 0; rep < NREP(3); ++rep) {
            const int t3 = opaque_tid(), lane3 = t3 & 63, wave3 = __builtin_amdgcn_readfirstlane(t3 >> 6);
            ssd_states_loop(F, t3, lane3, wave3);
            __syncthreads();
            for (int u = vwg(F.G); u < 64 * 8; u += F.G) na_wg_unit(F, l, u & 63, u >> 6, t3, lane3, wave3);
            __syncthreads();
        } SEAM(pb + 3);
        if (IN(pb + 4)) for (int rep = 0; rep < NREP(4); ++rep) {
            ssd_chunk_scan_phase(F);
            const int t3 = opaque_tid(), lane3 = t3 & 63, wave3 = __builtin_amdgcn_readfirstlane(t3 >> 6);
            LAS unsigned char* vbuf = F.lds + RING_OFF + wave3 * NA_VBUF;
            if (l < DEPTH - 1) for (int u = (int)blockIdx.x * NWAVES + wave3; u < 16 * 8; u += F.G * NWAVES) na_unit(F, l, u & 15, u >> 4, vbuf, lane3);
            const int rb0 = (l < DEPTH - 1) ? 0 : CTX / 16;
            pool_mm_wg(F, l, rb0, t3, lane3, wave3);
            __syncthreads();
        } SEAM(pb + 4);
        if (IN(pb + 5)) for (int rep = 0; rep < NREP(5); ++rep) {
            const int t3 = opaque_tid(), lane3 = t3 & 63, wave3 = __builtin_amdgcn_readfirstlane(t3 >> 6);
            ssd_out_loop(F, l, t3, lane3, wave3);
            __syncthreads();
        } SEAM(pb + 5);
        if (IN(pb + 6)) { for (int rep = 0; rep < NREP(6); ++rep) { ssd_gate_phase(F, l); __syncthreads(); } } SEAM(pb + 6);
        if (IN(pb + 7)) {
            { pg8::Gemm g{(const bf16*)(F.ws_() + WS_MIX), (const bf16*)(F.ws_() + WS_WOUT + l * SZ_WOUT), R, D, D, D, D}; pg8::StaticOrder S; S.init(SEQ, D, F.G, (int)blockIdx.x, 1);
              pg8::EpiResT<(l > 0), true> E{xin_l, X1 + (size_t)CTX * D, modp(F, l, 0, 2), D};
              pg8::gemm_phase<pg8::EpiResT<(l > 0), true>, pg8::StaticOrder, true, true>(F.lds + RING_OFF, g, S, E, opaque_tid()); }
            if (l < DEPTH - 1 && blockIdx.x < 256) { const int pn = (int)blockIdx.x & 15, ks = (int)blockIdx.x >> 4;
              pg8::Gemm g{(const bf16*)(F.ws_() + WS_MIX) + ks * 256, (const bf16*)(F.ws_() + WS_WOUT + l * SZ_WOUT) + ks * 256, CTX, D, 256, D, D}; pg8::OneUnit S{{0, pn}};
              pg8::EpiPart E{(float*)(F.ws_() + WS_SPK) + (size_t)ks * CTX * D, D};
              pg8::gemm_phase<pg8::EpiPart, pg8::OneUnit, true, true>(F.lds + RING_OFF, g, S, E, opaque_tid()); }
        } SEAM(pb + 7);
        if (IN(pb + 8)) for (int rep = 0; rep < NREP(8); ++rep) {
            if (l < DEPTH - 1) norm_mod_phase<true>(F, xin_c, X1 + (size_t)CTX * D, F.in_(I_N2W) + (size_t)l * D, l, 3, 4, (const float*)(F.ws_() + WS_SPK), modp(F, l, 1, 2), X1);
            else norm_mod_phase<true>(F, X1, X1 + (size_t)CTX * D, F.in_(I_N2W) + (size_t)l * D, l, 3, 4, nullptr, nullptr, nullptr, CTX);
        } SEAM(pb + 8);
        if (IN(pb + 9)) {
            pg8::Gemm g{(const bf16*)(F.ws_() + WS_H), (const bf16*)(F.ws_() + WS_WUP + l * SZ_WUP), R, DFF2, D, D, D}; pg8::StaticOrder S; S.init(l == DEPTH - 1 ? SEQ : R, DFF2, F.G, (int)blockIdx.x, l == DEPTH - 1 ? 1 : 0);
            pg8::EpiFFN E{(bf16*)(F.ws_() + WS_ACT), F.in_(I_MCW) + (size_t)l * 3 * DFF2, F.in_(I_MCB) + (size_t)l * DFF2, (pg8::bf16_t*)(F.ws_() + WS_E), DFF};
            pg8::gemm_phase<pg8::EpiFFN, pg8::StaticOrder, true, true>(F.lds + RING_OFF, g, S, E, opaque_tid());
        } SEAM(pb + 9);
        if (IN(pb + 10)) { for (int rep = 0; rep < NREP(10); ++rep) { ffn_edge_phase(F, l); __syncthreads(); } } SEAM(pb + 10);
        if (IN(pb + 11)) {
            { pg8::Gemm g{(const bf16*)(F.ws_() + WS_ACT), (const bf16*)(F.ws_() + WS_WDN + l * SZ_WDN), R, D, DFF, DFF, DFF}; pg8::StaticOrder S; S.init(SEQ, D, F.G, (int)blockIdx.x, 1);
              float* X2 = (float*)(F.ws_() + WS_X2);
              pg8::EpiResT<true, (l < DEPTH - 1)> E{X1 + (size_t)CTX * D, (l == DEPTH - 1) ? F.out_() : X2 + (size_t)CTX * D, modp(F, l, 0, 5), D};
              pg8::gemm_phase<pg8::EpiResT<true, (l < DEPTH - 1)>, pg8::StaticOrder, true, true>(F.lds + RING_OFF, g, S, E, opaque_tid()); }
            if (l < DEPTH - 1 && blockIdx.x < 256) { const int pn = (int)blockIdx.x & 15, ks = (int)blockIdx.x >> 4;
              const int koff = ks < 6 ? ks * 768 : 4608 + (ks - 6) * 640, kn = ks < 6 ? 768 : 640;
              pg8::Gemm g{(const bf16*)(F.ws_() + WS_ACT) + koff, (const bf16*)(F.ws_() + WS_WDN + l * SZ_WDN) + koff, CTX, D, kn, DFF, DFF}; pg8::OneUnit S{{0, pn}};
              pg8::EpiPart E{(float*)(F.ws_() + WS_SPK) + (size_t)ks * CTX * D, D};
              pg8::gemm_phase<pg8::EpiPart, pg8::OneUnit, true, true>(F.lds + RING_OFF, g, S, E, opaque_tid()); }
        } SEAM(pb + 11);
    }
#undef IN
#undef SEAM
}

extern "C" void kernel_launch(void* const* d_in, const int* in_sizes, int n_in, void* d_out, int out_size, void* d_ws, size_t ws_size, hipStream_t stream) {
    static int grid = 0;
    if (grid == 0) {
        if (n_in != 25 || out_size != SEQ * D || ws_size < WS_END2) { fprintf(stderr, "kernel_launch: unexpected problem shape (n_in %d, out %d, ws %zu, need %zu)\n", n_in, out_size, ws_size, (size_t)WS_END2); grid = -1; return; }
        int dev = 0, cus = 0, per_cu = 0;
        if (hipGetDevice(&dev) != hipSuccess || hipDeviceGetAttribute(&cus, hipDeviceAttributeMultiprocessorCount, dev) != hipSuccess) { grid = -1; return; }
        if (hipFuncSetAttribute((const void*)hymba_fwd, hipFuncAttributeMaxDynamicSharedMemorySize, LDS_BYTES) != hipSuccess) { fprintf(stderr, "kernel_launch: hipFuncSetAttribute failed\n"); grid = -1; return; }
        if (hipOccupancyMaxActiveBlocksPerMultiprocessor(&per_cu, (const void*)hymba_fwd, NWAVES * 64, LDS_BYTES) != hipSuccess || per_cu < 1) { fprintf(stderr, "kernel_launch: occupancy query says %d\n", per_cu); }
        (void)hipGetLastError();
        grid = cus;
    }
    if (grid < 0) return;
    (void)hipMemsetAsync((char*)d_ws + WS_CTL, 0, CTL_ZERO_BYTES, stream);
    Args a{};
    for (int i = 0; i < 25; ++i) a.in[i] = (const float*)d_in[i];
    a.out = (float*)d_out; a.ws = (unsigned char*)d_ws;
#if MK_ONE_LAUNCH
    a.ph_lo = 0; a.ph_hi = NPH;
    hipLaunchKernelGGL(hymba_fwd, dim3(grid), dim3(NWAVES * 64), LDS_BYTES, stream, a);
#else
    for (int k = 0; k < NPH; ++k) { a.ph_lo = k; a.ph_hi = k + 1; hipLaunchKernelGGL(hymba_fwd, dim3(grid), dim3(NWAVES * 64), LDS_BYTES, stream, a); }
#endif
}
```

```cpp
#include <hip/hip_runtime.h>
#include <cstdio>
#include <cstdint>

namespace pg8 {
#define PG8_LAS __attribute__((address_space(3)))
typedef unsigned short bf16_t;
typedef short bf16x8 __attribute__((ext_vector_type(8)));
typedef float f32x4 __attribute__((ext_vector_type(4)));
typedef unsigned u32x4 __attribute__((ext_vector_type(4)));
constexpr int BM = 256, BK = 64, HALF = 128, HTB = HALF * BK * 2, STAGE_BYTES = 8 * HTB, NXCD = 8, WGM = 4;

__host__ __device__ __forceinline__ int lds_byte(int r, int c) { const int st = (r >> 4) * 2 + (c >> 5), rr = r & 15, cc = c & 31, ob = rr * 64 + cc * 2; return st * 1024 + (ob ^ (((ob >> 9) & 1) << 5)); }
__host__ __device__ __forceinline__ void stage_rc(int b, int& R, int& C) { const int st = b / 1024, sb = b % 1024, swz = sb ^ (((sb >> 9) & 1) << 5); R = (st >> 1) * 16 + swz / 64; C = (st & 1) * 32 + (swz % 64) / 2; }
__host__ __device__ __forceinline__ int perm32(int rho) { const int n = rho >> 4, i = rho & 15; return 8 * (i >> 2) + 4 * n + (i & 3); }

struct Unit { int pm, pn; };
struct Gemm { const bf16_t* A; const bf16_t* Bt; int M, N, K, lda, ldb; };

struct StaticOrder {
    int nM, nN, nwg, G, c, pm0;
    __host__ __device__ void init(int M, int N, int G_, int c_, int pm0_ = 0) { nM = M / BM; nN = N / BM; nwg = nM * nN; G = G_; c = c_; pm0 = pm0_; }
    __host__ __device__ bool next(int i, Unit& u) const {
        const long L = (long)i * G + c; if (L >= nwg) return false;
        int wgid = (int)L; { const int q = nwg / NXCD, r = nwg % NXCD, xcd = wgid % NXCD, off = wgid / NXCD; wgid = (xcd < r ? xcd * (q + 1) : r * (q + 1) + (xcd - r) * q) + off; }
        const int nig = WGM * nN, gid = wgid / nig, fm = gid * WGM, gsz = (nM - fm) < WGM ? (nM - fm) : WGM;
        u.pm = pm0 + fm + ((wgid % nig) % gsz); u.pn = (wgid % nig) / gsz; return true;
    }
    __device__ __forceinline__ void a_ready(const Unit&) const {}
    __device__ __forceinline__ void done(const Unit&) const {}
};

__device__ __forceinline__ unsigned cvt_pk_bf16(float lo, float hi) { unsigned r; asm volatile("v_cvt_pk_bf16_f32 %0, %1, %2" : "=v"(r) : "v"(lo), "v"(hi)); return r; }

struct EpiBf16 {
    static constexpr bool PERM = true, AFTER_DRAIN = false;
    bf16_t* O; int ldc;
    __device__ __forceinline__ void operator()(const f32x4 (&acc)[2][2][4][2], const Unit& u, int wr, int wc, int fr, int fq) const {
        const int row0 = u.pm * BM + wr * 64 + fr; const int col0 = u.pn * BM + wc * 32 + 8 * fq;
#pragma unroll
        for (int ai = 0; ai < 2; ++ai)
#pragma unroll
            for (int m = 0; m < 4; ++m) { bf16_t* rowp = O + (size_t)(row0 + ai * HALF + m * 16) * ldc + col0;
#pragma unroll
                for (int bj = 0; bj < 2; ++bj) { const f32x4 v0 = acc[ai][bj][m][0], v1 = acc[ai][bj][m][1];
                    u32x4 w; w.x = cvt_pk_bf16(v0[0], v0[1]); w.y = cvt_pk_bf16(v0[2], v0[3]); w.z = cvt_pk_bf16(v1[0], v1[1]); w.w = cvt_pk_bf16(v1[2], v1[3]);
                    *(u32x4*)(rowp + bj * HALF) = w; } }
    }
};
template <bool BB, bool OB>
struct EpiResT {
    static constexpr bool PERM = true, AFTER_DRAIN = false;
    const void* base_l; void* out_l; const float* gate_l; int ldc;
    __device__ __forceinline__ void operator()(const f32x4 (&acc)[2][2][4][2], const Unit& u, int wr, int wc, int fr, int fq) const {
        const int row0 = (u.pm - 1) * BM + wr * 64 + fr, col0 = u.pn * BM + wc * 32 + 8 * fq;
        f32x4 gv[2][2];
#pragma unroll
        for (int bj = 0; bj < 2; ++bj)
#pragma unroll
            for (int n = 0; n < 2; ++n) gv[bj][n] = *(const f32x4*)(gate_l + col0 + bj * HALF + n * 4);
        constexpr int RD = BB ? 8 : 4;
        f32x4 bs[RD][BB ? 1 : 4]; u32x4 bh[RD][BB ? 2 : 1];
#define ERES_LOAD(buf, grp) do { const size_t off_ = (size_t)(row0 + ((grp) >> 2) * HALF + ((grp) & 3) * 16) * ldc + col0; \
            if constexpr (BB) { _Pragma("unroll") for (int bj = 0; bj < 2; ++bj) bh[buf][bj] = *(const u32x4*)((const bf16_t*)base_l + off_ + bj * HALF); } \
            else { _Pragma("unroll") for (int bj = 0; bj < 2; ++bj) _Pragma("unroll") for (int n = 0; n < 2; ++n) bs[buf][bj * 2 + n] = *(const f32x4*)((const float*)base_l + off_ + bj * HALF + n * 4); } } while (0)
#pragma unroll
        for (int g0 = 0; g0 < RD - 1; ++g0) ERES_LOAD(g0, g0);
#pragma unroll
        for (int grp = 0; grp < 8; ++grp) { const int ai = grp >> 2, m = grp & 3; const size_t off = (size_t)(row0 + ai * HALF + m * 16) * ldc + col0;
            if (grp + RD - 1 < 8) ERES_LOAD((grp + RD - 1) % RD, grp + RD - 1);
#pragma unroll
            for (int bj = 0; bj < 2; ++bj) {
                f32x4 r[2];
#pragma unroll
                for (int n = 0; n < 2; ++n) {
                    f32x4 b;
                    if constexpr (BB) { const unsigned w0 = bh[grp % RD][bj][2 * n], w1 = bh[grp % RD][bj][2 * n + 1];
                        b = (f32x4){__uint_as_float(w0 << 16), __uint_as_float(w0 & 0xffff0000u), __uint_as_float(w1 << 16), __uint_as_float(w1 & 0xffff0000u)}; }
                    else b = bs[grp % RD][bj * 2 + n];
                    r[n] = b + gv[bj][n] * acc[ai][bj][m][n]; }
                if constexpr (OB) { u32x4 w; w.x = cvt_pk_bf16(r[0][0], r[0][1]); w.y = cvt_pk_bf16(r[0][2], r[0][3]); w.z = cvt_pk_bf16(r[1][0], r[1][1]); w.w = cvt_pk_bf16(r[1][2], r[1][3]);
                    *(u32x4*)((bf16_t*)out_l + off + bj * HALF) = w; }
                else { *(f32x4*)((float*)out_l + off + bj * HALF) = r[0]; *(f32x4*)((float*)out_l + off + bj * HALF + 4) = r[1]; } }
            asm volatile("" ::: "memory"); }
#undef ERES_LOAD
    }
};
struct OneUnit {
    Unit u;
    __device__ __forceinline__ bool next(int i, Unit& o) const { if (i != 0) return false; o = u; return true; }
    __device__ __forceinline__ void a_ready(const Unit&) const {}
    __device__ __forceinline__ void done(const Unit&) const {}
};
struct EpiPart {
    static constexpr bool PERM = true, AFTER_DRAIN = false;
    float* C; int ldc;
    __device__ __forceinline__ void operator()(const f32x4 (&acc)[2][2][4][2], const Unit& u, int wr, int wc, int fr, int fq) const {
        const int row0 = wr * 64 + fr, col0 = u.pn * BM + wc * 32 + 8 * fq;
#pragma unroll
        for (int ai = 0; ai < 2; ++ai)
#pragma unroll
            for (int m = 0; m < 4; ++m) { float* rowp = C + (size_t)(row0 + ai * HALF + m * 16) * ldc + col0;
#pragma unroll
                for (int bj = 0; bj < 2; ++bj)
#pragma unroll
                    for (int n = 0; n < 2; ++n) *(f32x4*)(rowp + bj * HALF + n * 4) = acc[ai][bj][m][n]; }
    }
};
__device__ __forceinline__ float dpp_shr1(float edge, float v) { return __builtin_bit_cast(float, __builtin_amdgcn_update_dpp(__builtin_bit_cast(int, edge), __builtin_bit_cast(int, v), 0x111, 0xf, 0xf, false)); }
__device__ __forceinline__ float dpp_shl1(float edge, float v) { return __builtin_bit_cast(float, __builtin_amdgcn_update_dpp(__builtin_bit_cast(int, edge), __builtin_bit_cast(int, v), 0x101, 0xf, 0xf, false)); }
template <int N> __device__ __forceinline__ float dpp_ror(float v) { return __builtin_bit_cast(float, __builtin_amdgcn_mov_dpp(__builtin_bit_cast(int, v), 0x120 + N, 0xf, 0xf, true)); }
struct EpiFFN {
    static constexpr bool PERM = true, AFTER_DRAIN = false;
    bf16_t* ACT; const float* cw; const float* cb; bf16_t* E; int dff;
    __device__ __forceinline__ void operator()(const f32x4 (&acc)[2][2][4][2], const Unit& u, int wr, int wc, int fr, int fq) const {
        typedef unsigned u32x2 __attribute__((ext_vector_type(2)));
        u32x2 pend[2][4];
#pragma unroll
        for (int n = 0; n < 2; ++n) {
            const int ch = u.pn * HALF + wc * 32 + 8 * fq + 4 * n;
            const f32x4 g0 = *(const f32x4*)(cw + ch), g1 = *(const f32x4*)(cw + 2 * dff + ch), g2 = *(const f32x4*)(cw + 4 * dff + ch), gb = *(const f32x4*)(cb + ch);
            const f32x4 v0 = *(const f32x4*)(cw + dff + ch), v1 = *(const f32x4*)(cw + 3 * dff + ch), v2 = *(const f32x4*)(cw + 5 * dff + ch), vb = *(const f32x4*)(cb + dff + ch);
#pragma unroll
            for (int ai = 0; ai < 2; ++ai) {
                const int blk = 4 * u.pm + 2 * ai + wr;
#pragma unroll
                for (int m = 0; m < 4; ++m) {
                    const f32x4 gc = acc[ai][0][m][n], vc = acc[ai][1][m][n];
                    const f32x4 gpm = acc[ai][0][m > 0 ? m - 1 : 0][n], vpm = acc[ai][1][m > 0 ? m - 1 : 0][n];
                    const f32x4 gnm = acc[ai][0][m < 3 ? m + 1 : 3][n], vnm = acc[ai][1][m < 3 ? m + 1 : 3][n];
                    f32x4 gu, gd, vu, vd;
#pragma unroll
                    for (int e = 0; e < 4; ++e) {
                        gu[e] = dpp_shr1(dpp_ror<1>(gpm[e]), gc[e]); vu[e] = dpp_shr1(dpp_ror<1>(vpm[e]), vc[e]);
                        gd[e] = dpp_shl1(dpp_ror<15>(gnm[e]), gc[e]); vd[e] = dpp_shl1(dpp_ror<15>(vnm[e]), vc[e]); }
                    const f32x4 G = gb + g0 * gu + g1 * gc + g2 * gd, V = vb + v0 * vu + v1 * vc + v2 * vd;
                    const int rho = 16 * m + fr;
                    float o[4];
#pragma unroll
                    for (int e = 0; e < 4; ++e) o[e] = G[e] * __builtin_amdgcn_rcpf(1.f + __expf(-G[e])) * V[e];
                    u32x2 w; w.x = cvt_pk_bf16(o[0], o[1]); w.y = cvt_pk_bf16(o[2], o[3]);
                    if (n == 0) pend[ai][m] = w;
                    else if (rho != 0 && rho != 63) { u32x4 w4; w4.x = pend[ai][m].x; w4.y = pend[ai][m].y; w4.z = w.x; w4.w = w.y;
                        *(u32x4*)(ACT + (size_t)(u.pm * BM + ai * HALF + wr * 64 + rho) * dff + ch - 4) = w4; }
                    if ((m == 0 && fr < 2) || (m == 3 && fr >= 14)) {
                        const int slot = (m == 0) ? fr : fr - 12;
                        bf16_t* ep = E + ((size_t)(blk * 4 + slot) * 2 * dff) + u.pn * BM + wc * 32 + 8 * fq + 4 * n;
                        u32x2 eg, ev; eg.x = cvt_pk_bf16(gc[0], gc[1]); eg.y = cvt_pk_bf16(gc[2], gc[3]); ev.x = cvt_pk_bf16(vc[0], vc[1]); ev.y = cvt_pk_bf16(vc[2], vc[3]);
                        *(u32x2*)ep = eg; *(u32x2*)(ep + HALF) = ev;
                    }
                }
            }
        }
    }
};

template <class Epi, class Sched, bool ALIGN_EPI = false, bool SP2 = false>
__device__ __forceinline__ void gemm_phase(PG8_LAS unsigned char* lds, const Gemm g, const Sched& S, const Epi& E, int tid) {
    asm volatile("" : "+v"(tid));
    const int wid = __builtin_amdgcn_readfirstlane(tid >> 6), lane = tid & 63, wr = wid >> 2, wc = wid & 3, fr = lane & 15, fq = lane >> 4;
    const int K = g.K, nt = K / BK;
    unsigned voffA[2], voffB[2];
#pragma unroll
    for (int i = 0; i < 2; ++i) { int R, C; stage_rc(tid * 16 + i * 8192, R, C); const int Rb = Epi::PERM ? ((R & ~31) + perm32(R & 31)) : R;
        voffA[i] = (unsigned)(R * g.lda + C) * 2u; voffB[i] = (unsigned)(Rb * g.ldb + C) * 2u; }
    const size_t kstep = (size_t)(BK * 2);
    const size_t hstepA = (size_t)HALF * g.lda * 2, hstepB = (size_t)HALF * g.ldb * 2;
    const size_t tstepA = 2 * hstepA, tstepB = 2 * hstepB;
    const unsigned ldsw = (unsigned)wid * 1024u;
    const int aoff = lds_byte(wr * 64 + fr, fq * 8), boff = lds_byte(wc * 32 + fr, fq * 8);
#define PG8_SA(b, h) (((b) * 2 + (h)) * HTB)
#define PG8_SB(b, h) ((4 + (b) * 2 + (h)) * HTB)
#define PG8_STAGE(bufoff, gbase, voff) do { _Pragma("unroll") for (int _i = 0; _i < 2; ++_i) \
        __builtin_amdgcn_global_load_lds((const unsigned*)((const char*)(gbase) + (voff)[_i]), (PG8_LAS unsigned*)(lds + (bufoff) + ldsw + _i * 8192), 16, 0, 0); } while (0)
#define PG8_LDA(dst, b, h) do { _Pragma("unroll") for (int m = 0; m < 4; ++m) _Pragma("unroll") for (int k = 0; k < 2; ++k) dst[m][k] = *(const PG8_LAS bf16x8*)(lds + PG8_SA(b, h) + aoff + m * 2048 + k * 1024); } while (0)
#define PG8_LDB(dst, b, h) do { _Pragma("unroll") for (int n = 0; n < 2; ++n) _Pragma("unroll") for (int k = 0; k < 2; ++k) dst[n][k] = *(const PG8_LAS bf16x8*)(lds + PG8_SB(b, h) + boff + n * 2048 + k * 1024); } while (0)
#define PG8_MMA(ai, bj, At, Bt) do { __builtin_amdgcn_s_setprio(1); _Pragma("unroll") for (int m = 0; m < 4; ++m) _Pragma("unroll") for (int n = 0; n < 2; ++n) _Pragma("unroll") for (int k = 0; k < 2; ++k) \
        acc[ai][bj][m][n] = __builtin_amdgcn_mfma_f32_16x16x32_bf16(Bt[n][k], At[m][k], acc[ai][bj][m][n], 0, 0, 0); __builtin_amdgcn_s_setprio(0); } while (0)
#define PG8_WAIT_V(n) asm volatile("s_waitcnt vmcnt(" #n ")" ::: "memory")
#define PG8_WAIT_L(n) asm volatile("s_waitcnt lgkmcnt(" #n ")" ::: "memory")
#define PG8_BAR __builtin_amdgcn_s_barrier()
#define PG8_SCHED __builtin_amdgcn_sched_barrier(0)
    Unit cur, nxt; int ui = 0;
    if (!S.next(0, cur)) return;
    f32x4 acc[2][2][4][2];
#pragma unroll
    for (int a = 0; a < 2; ++a)
#pragma unroll
        for (int b = 0; b < 2; ++b)
#pragma unroll
            for (int m = 0; m < 4; ++m)
#pragma unroll
                for (int n = 0; n < 2; ++n) acc[a][b][m][n] = (f32x4){0.f, 0.f, 0.f, 0.f};
    bf16x8 At[4][2], B0[2][2], B1[2][2];
    const char* cA = (const char*)g.A + (size_t)cur.pm * tstepA; const char* cB = (const char*)g.Bt + (size_t)cur.pn * tstepB;
    S.a_ready(cur);
    if constexpr (SP2) {
        PG8_STAGE(PG8_SB(0, 0), cB, voffB); PG8_STAGE(PG8_SB(0, 1), cB + hstepB, voffB); PG8_STAGE(PG8_SA(0, 0), cA, voffA); PG8_STAGE(PG8_SA(0, 1), cA + hstepA, voffA);
        if (wr == 1) PG8_BAR;
        PG8_WAIT_V(2); PG8_BAR;
        PG8_STAGE(PG8_SB(1, 0), cB + kstep, voffB); PG8_STAGE(PG8_SA(1, 0), cA + kstep, voffA); PG8_STAGE(PG8_SB(1, 1), cB + hstepB + kstep, voffB);
        PG8_WAIT_V(6); PG8_BAR;
    } else {
        PG8_STAGE(PG8_SB(0, 0), cB, voffB); PG8_STAGE(PG8_SA(0, 0), cA, voffA); PG8_STAGE(PG8_SB(0, 1), cB + hstepB, voffB); PG8_STAGE(PG8_SA(0, 1), cA + hstepA, voffA);
        if (wr == 1) PG8_BAR;
        PG8_WAIT_V(4); PG8_BAR;
        PG8_STAGE(PG8_SB(1, 0), cB + kstep, voffB); PG8_STAGE(PG8_SA(1, 0), cA + kstep, voffA); PG8_STAGE(PG8_SB(1, 1), cB + hstepB + kstep, voffB);
        PG8_WAIT_V(6); PG8_BAR;
    }
    for (;;) {
        const bool has_next = S.next(ui + 1, nxt);
        const char* nA = has_next ? (const char*)g.A + (size_t)nxt.pm * tstepA : cA; const char* nB = has_next ? (const char*)g.Bt + (size_t)nxt.pn * tstepB : cB;
        for (int t = 0; t < nt; t += 2) {
            const bool last = (t == nt - 2);
            const char* a1 = cA + (size_t)(t + 1) * kstep;
            const char* a2 = last ? nA : cA + (size_t)(t + 2) * kstep; const char* b2 = last ? nB : cB + (size_t)(t + 2) * kstep;
            const char* a3 = a2 + kstep; const char* b3 = b2 + kstep;
            if (last && has_next) S.a_ready(nxt);
            if constexpr (SP2) {
            PG8_LDB(B0, 0, 0); PG8_LDB(B1, 0, 1); PG8_SCHED; PG8_LDA(At, 0, 0); PG8_STAGE(PG8_SA(1, 1), a1 + hstepA, voffA);
            PG8_WAIT_V(8); PG8_WAIT_L(0); PG8_BAR; PG8_MMA(0, 0, At, B0); PG8_MMA(0, 1, At, B1); PG8_BAR; PG8_SCHED;
            PG8_LDA(At, 0, 1); PG8_STAGE(PG8_SB(0, 0), b2, voffB); PG8_STAGE(PG8_SB(0, 1), b2 + hstepB, voffB); PG8_STAGE(PG8_SA(0, 0), a2, voffA);
            PG8_WAIT_V(8); PG8_WAIT_L(0); PG8_BAR; PG8_MMA(1, 0, At, B0); PG8_MMA(1, 1, At, B1); PG8_BAR; PG8_SCHED;
            PG8_LDB(B0, 1, 0); PG8_LDB(B1, 1, 1); PG8_SCHED; PG8_LDA(At, 1, 0); PG8_STAGE(PG8_SA(0, 1), a2 + hstepA, voffA);
            PG8_WAIT_V(8); PG8_WAIT_L(0); PG8_BAR; PG8_MMA(0, 0, At, B0); PG8_MMA(0, 1, At, B1); PG8_BAR; PG8_SCHED;
            PG8_LDA(At, 1, 1); PG8_STAGE(PG8_SB(1, 0), b3, voffB); PG8_STAGE(PG8_SB(1, 1), b3 + hstepB, voffB); PG8_STAGE(PG8_SA(1, 0), a3, voffA);
            PG8_WAIT_V(8); PG8_WAIT_L(0); PG8_BAR; PG8_MMA(1, 0, At, B0); PG8_MMA(1, 1, At, B1); PG8_BAR; PG8_SCHED;
            } else {
            PG8_LDB(B0, 0, 0); PG8_SCHED; PG8_LDA(At, 0, 0); PG8_STAGE(PG8_SA(1, 1), a1 + hstepA, voffA);
            PG8_WAIT_L(8); PG8_BAR; PG8_WAIT_L(0); PG8_MMA(0, 0, At, B0); PG8_BAR; PG8_SCHED;
            PG8_LDB(B1, 0, 1); PG8_STAGE(PG8_SB(0, 0), b2, voffB);
            PG8_BAR; PG8_WAIT_L(0); PG8_MMA(0, 1, At, B1); PG8_BAR;
            PG8_LDA(At, 0, 1); PG8_STAGE(PG8_SA(0, 0), a2, voffA);
            PG8_BAR; PG8_WAIT_L(0); PG8_MMA(1, 0, At, B0); PG8_BAR; PG8_SCHED;
            PG8_STAGE(PG8_SB(0, 1), b2 + hstepB, voffB);
            PG8_WAIT_V(6); PG8_BAR; PG8_MMA(1, 1, At, B1); PG8_BAR;
            PG8_LDB(B0, 1, 0); PG8_SCHED; PG8_LDA(At, 1, 0); PG8_STAGE(PG8_SA(0, 1), a2 + hstepA, voffA);
            PG8_WAIT_L(8); PG8_BAR; PG8_WAIT_L(0); PG8_MMA(0, 0, At, B0); PG8_BAR; PG8_SCHED;
            PG8_LDB(B1, 1, 1); PG8_STAGE(PG8_SB(1, 0), b3, voffB);
            PG8_BAR; PG8_WAIT_L(0); PG8_MMA(0, 1, At, B1); PG8_BAR;
            PG8_LDA(At, 1, 1); PG8_STAGE(PG8_SA(1, 0), a3, voffA);
            PG8_BAR; PG8_WAIT_L(0); PG8_MMA(1, 0, At, B0); PG8_BAR; PG8_SCHED;
            PG8_STAGE(PG8_SB(1, 1), b3 + hstepB, voffB);
            PG8_WAIT_V(6); PG8_BAR; PG8_MMA(1, 1, At, B1); PG8_BAR;
            }
        }
        if constexpr (ALIGN_EPI) { if (wr == 0) PG8_BAR; }
        if constexpr (!Epi::AFTER_DRAIN) { E(acc, cur, wr, wc, fr, fq); S.done(cur); }
        if (!has_next) break;
#pragma unroll
        for (int a = 0; a < 2; ++a)
#pragma unroll
            for (int b = 0; b < 2; ++b)
#pragma unroll
                for (int m = 0; m < 4; ++m)
#pragma unroll
                    for (int n = 0; n < 2; ++n) acc[a][b][m][n] = (f32x4){0.f, 0.f, 0.f, 0.f};
        cur = nxt; cA = nA; cB = nB; ++ui;
        if constexpr (ALIGN_EPI) { if (wr == 1) PG8_BAR; }
    }
    PG8_WAIT_V(0);
    if constexpr (!ALIGN_EPI) { if (wr == 0) PG8_BAR; }
    PG8_BAR;
#undef PG8_SA
#undef PG8_SB
#undef PG8_STAGE
#undef PG8_LDA
#undef PG8_LDB
#undef PG8_MMA
#undef PG8_WAIT_V
#undef PG8_WAIT_L
#undef PG8_BAR
#undef PG8_SCHED
}
}

constexpr int NWAVES = 8;
#ifndef MK_ONE_LAUNCH
#define MK_ONE_LAUNCH 1
#endif

#ifndef PROBE_DUP
#define PROBE_DUP -1
#endif
#define NREP(k) ((PROBE_DUP) == (k) ? 2 : 1)
constexpr int D = 4096, SEQ = 16384, CTX = 256, R = SEQ + CTX;
constexpr int DEPTH = 2;
constexpr int IN_COLS = 9280, NIN = 9472;
constexpr int OFF_Z = 0, OFF_Q = 2048, OFF_POOL = 3072, OFF_XBC = 4096, OFF_DT = 7168, OFF_K = 7232, OFF_V = 8256;
constexpr int SSD_DI = 2048, SSD_XBC = 3072, SSD_GN = 512;
constexpr int DFF = 11008, DFF2 = 22016;
constexpr int GRID_W = 64;
constexpr float RMS_EPS = 1e-6f;
constexpr int NMOD = 6 * D;
constexpr int NCHUNK = R / 128;

constexpr size_t MiB = 1u << 20;
constexpr size_t al(size_t x) { return (x + 4095) & ~(size_t)4095; }
constexpr size_t WS_CTL = 0, CTL_ZERO_BYTES = 1 * MiB;
constexpr size_t SZ_WIN = (size_t)NIN * D * 2, SZ_WOUT = (size_t)D * D * 2, SZ_WUP = (size_t)DFF2 * D * 2, SZ_WDN = (size_t)D * DFF * 2;
constexpr size_t WS_WIN = 1 * MiB;
constexpr size_t WS_WOUT = WS_WIN + 2 * SZ_WIN;
constexpr size_t WS_WUP = WS_WOUT + 2 * SZ_WOUT;
constexpr size_t WS_WDN = WS_WUP + 2 * SZ_WUP;
constexpr size_t WS_MOD = WS_WDN + 2 * SZ_WDN;
constexpr size_t WS_PART = al(WS_MOD + (size_t)2 * 2 * NMOD * 4);
constexpr size_t WS_WPOOL = al(WS_PART + (size_t)2 * 32 * 2 * NMOD * 4);
constexpr size_t WS_NAB = al(WS_WPOOL + (size_t)8 * 65536 * 2);
constexpr size_t WS_ROPE = al(WS_NAB + 64);
constexpr size_t WS_DT = al(WS_ROPE + 256 * 32 * 8);
constexpr size_t WS_H = al(WS_DT + (size_t)2 * R * 64 * 4);
constexpr size_t WS_MIX = al(WS_H + (size_t)R * D * 2);
constexpr size_t WS_X1 = al(WS_MIX + (size_t)R * D * 2);
constexpr size_t WS_X2 = al(WS_X1 + (size_t)R * D * 4);
constexpr size_t WS_ACT = al(WS_X2 + (size_t)R * D * 4);
constexpr size_t WS_OV = al(WS_ACT + (size_t)R * DFF * 2);
constexpr size_t WS_P = WS_OV;
constexpr size_t WS_XBC = al(WS_P + (size_t)R * NIN * 2);
constexpr size_t WS_Y = al(WS_XBC + (size_t)R * SSD_XBC * 2);
constexpr size_t WS_SEND = al(WS_Y + (size_t)R * SSD_DI * 4);
constexpr size_t WS_HIN = al(WS_SEND + (size_t)NCHUNK * 64 * 8192 * 4);
constexpr size_t WS_CHD = al(WS_HIN + (size_t)NCHUNK * 64 * 8192 * 2);
constexpr size_t WS_QN = al(WS_CHD + (size_t)NCHUNK * 64 * 4);
constexpr size_t WS_KN = al(WS_QN + (size_t)R * 1024 * 2);
constexpr size_t WS_PL = al(WS_KN + (size_t)R * 1024 * 2);
constexpr size_t WS_OV_END1 = al(WS_PL + (size_t)R * 1024 * 2);
constexpr size_t WS_E = WS_OV;
constexpr size_t WS_OV_END2 = al(WS_E + (size_t)(R / 64) * 4 * DFF2 * 4);
constexpr size_t WS_END = WS_OV_END1 > WS_OV_END2 ? WS_OV_END1 : WS_OV_END2;
constexpr size_t WS_SPK = WS_END;
constexpr size_t WS_END2 = WS_SPK + (size_t)16 * CTX * D * 4;
static_assert(WS_END2 <= (size_t)3072 * MiB, "d_ws map exceeds 3 GiB");

constexpr int CW_BAR = 4096;

constexpr int RING_OFF = 0, RING_BYTES = 144384;
constexpr int TIDTAB_OFF = RING_BYTES, TIDTAB_BYTES = 64 * 64 * 4;
constexpr int LDSCTL_OFF = TIDTAB_OFF + TIDTAB_BYTES, MISC_OFF = LDSCTL_OFF + 320;
constexpr int LDS_BYTES = 163840;

#define GAS __attribute__((address_space(1)))
#define LAS __attribute__((address_space(3)))
typedef unsigned short bf16;
typedef unsigned v4u __attribute__((ext_vector_type(4)));
typedef unsigned v2u __attribute__((ext_vector_type(2)));
typedef float f32x4 __attribute__((ext_vector_type(4)));
typedef float f32x2 __attribute__((ext_vector_type(2)));
typedef GAS unsigned gu32;
#define RLX_AGENT __ATOMIC_RELAXED, __HIP_MEMORY_SCOPE_AGENT
#define LDS_WAIT() asm volatile("s_waitcnt lgkmcnt(0)" ::: "memory")
#define VM_WAIT() asm volatile("s_waitcnt vmcnt(0)" ::: "memory")
__device__ __forceinline__ unsigned f2bf(float f) { unsigned u = __builtin_bit_cast(unsigned, f); return (u + 0x7fffu + ((u >> 16) & 1u)) >> 16; }
__device__ __forceinline__ unsigned pk2(float lo, float hi) { return f2bf(lo) | (f2bf(hi) << 16); }
__device__ __forceinline__ float bflo(unsigned w) { return __uint_as_float(w << 16); }
__device__ __forceinline__ float bfhi(unsigned w) { return __uint_as_float(w & 0xffff0000u); }
__device__ __forceinline__ float bf2f(bf16 b) { return __uint_as_float((unsigned)b << 16); }
__device__ __forceinline__ float silu_f(float v) { return v * __builtin_amdgcn_rcpf(1.f + __expf(-v)); }
__device__ __forceinline__ float wave_sum(float v) {
#pragma unroll
    for (int o = 1; o < 64; o <<= 1) v += __shfl_xor(v, o);
    return v;
}
__device__ __forceinline__ float wave_max(float v) {
#pragma unroll
    for (int o = 1; o < 64; o <<= 1) v = fmaxf(v, __shfl_xor(v, o));
    return v;
}

__device__ __forceinline__ int opaque_tid() {
    unsigned slot = (unsigned)__builtin_amdgcn_s_getreg((5 << 11) | 4) & 63u; asm volatile("" : "+s"(slot));
    unsigned lane; asm volatile("v_mbcnt_lo_u32_b32 %0, -1, 0\n\tv_mbcnt_hi_u32_b32 %0, -1, %0" : "=v"(lane));
    int t = *(const LAS int*)(size_t)((unsigned)TIDTAB_OFF + slot * 256u + lane * 4u); asm volatile("" : "+v"(t)); return t; }
#define XB_TMO      128
#define XB_XCNT(j)  (256  + 64 * (j))
#define XB_XSUB(j)  (1280 + 64 * (j))
#define XB_XGEN(j)  (2304 + 64 * (j))
#define XB_TOP      3328
#define XB_TOPGEN   3392
#define XCD_BAR_WORDS 3456
#define XB_SPIN_CAP (1u << 22)

__device__ __forceinline__ unsigned xb_ld(unsigned* p)              { return __hip_atomic_load(p, __ATOMIC_RELAXED, __HIP_MEMORY_SCOPE_AGENT); }
__device__ __forceinline__ unsigned xb_add(unsigned* p, unsigned v) { return __hip_atomic_fetch_add(p, v, __ATOMIC_RELAXED, __HIP_MEMORY_SCOPE_AGENT); }
__device__ __forceinline__ unsigned xb_xcc_id() { return (unsigned)__builtin_amdgcn_s_getreg((3 << 11) | 20) & 0xFu; }
#define XB_SPIN(cond, bar) do { unsigned _sp = 0; while (cond) { __builtin_amdgcn_s_sleep(1); \
    if ((++_sp & 255u) == 0u) { if (xb_ld(&(bar)[XB_TMO])) break; if (_sp > XB_SPIN_CAP) { atomicAdd(&(bar)[XB_TMO], 1u); break; } } } } while (0)

struct XcdBarrier { unsigned* bar; unsigned x; volatile LAS unsigned* st; };

__device__ __forceinline__ XcdBarrier xcd_barrier_post(unsigned* bar, volatile LAS unsigned* st) {
    XcdBarrier b; b.bar = bar; b.x = xb_xcc_id(); b.st = st;
    if (opaque_tid() == 0) (void)xb_add(&bar[XB_XCNT(b.x)], 1u);
    return b;
}
__device__ __forceinline__ void xcd_barrier_complete(unsigned* bar, unsigned x, unsigned& nloc, unsigned& nx) {
    const unsigned G = gridDim.x * gridDim.y * gridDim.z;
    unsigned sum, cnt, mine, sp = 0u;
    for (;;) {
        sum = 0u; cnt = 0u; mine = 0u;
#pragma unroll
        for (unsigned j = 0; j < 16; ++j) { const unsigned c = xb_ld(&bar[XB_XCNT(j)]); sum += c; cnt += (c > 0u) ? 1u : 0u; mine = (j == x) ? c : mine; }
        if (sum == G) break;
        __builtin_amdgcn_s_sleep(1);
        if ((++sp & 255u) == 0u) { if (xb_ld(&bar[XB_TMO])) break; if (sp > XB_SPIN_CAP) { atomicAdd(&bar[XB_TMO], 1u); break; } }
    }
    nloc = mine > 0u ? mine : 1u; nx = cnt > 0u ? cnt : 1u;
}
__device__ __forceinline__ void xcd_barrier(const XcdBarrier& b) {
    asm volatile("s_waitcnt vmcnt(0)" ::: "memory");
    __syncthreads();
    if (opaque_tid() == 0) {
        unsigned* bar = b.bar;
        __builtin_amdgcn_s_waitcnt(0);
        unsigned nloc = b.st[0], nx = b.st[1];
        if (nloc == 0u) { xcd_barrier_complete(bar, b.x, nloc, nx); b.st[0] = nloc; b.st[1] = nx; }
        const unsigned old = xb_add(&bar[XB_XSUB(b.x)], 1u);
        const unsigned gen = old / nloc;
        if (old + 1u == (gen + 1u) * nloc) {
            __builtin_amdgcn_fence(__ATOMIC_RELEASE, "agent");
            asm volatile("s_waitcnt vmcnt(0)" ::: "memory");
            const unsigned og = xb_add(&bar[XB_TOP], 1u);
            const unsigned tg = og / nx;
            if (og + 1u == (tg + 1u) * nx) xb_add(&bar[XB_TOPGEN], 1u);
            else XB_SPIN(xb_ld(&bar[XB_TOPGEN]) == tg, bar);
            __builtin_amdgcn_fence(__ATOMIC_ACQUIRE, "agent");
            xb_add(&bar[XB_XGEN(b.x)], 1u);
            asm volatile("s_waitcnt vmcnt(0)" ::: "memory");
        } else {
            XB_SPIN(xb_ld(&bar[XB_XGEN(b.x)]) == gen, bar);
            __builtin_amdgcn_fence(__ATOMIC_ACQUIRE, "agent");
            asm volatile("s_waitcnt vmcnt(0)" ::: "memory");
        }
    }
    __syncthreads();
}


struct Frame {
    LAS unsigned char* lds;
    volatile LAS unsigned* MISC;
    gu32* ctl;
    int G;
    __device__ __forceinline__ const unsigned char __attribute__((address_space(4)))* kargs() const { const unsigned char __attribute__((address_space(4)))* k = (const unsigned char __attribute__((address_space(4)))*)__builtin_amdgcn_kernarg_segment_ptr(); asm volatile("" : "+s"(k)); return k; }
    __device__ __forceinline__ unsigned char* ws_() const { return *(unsigned char* const __attribute__((address_space(4)))*)(kargs() + 208); }
    __device__ __forceinline__ float* out_() const { return *(float* const __attribute__((address_space(4)))*)(kargs() + 200); }
    __device__ __forceinline__ const float* in_(int i) const { return ((const float* const __attribute__((address_space(4)))*)kargs())[i]; }
};
enum { I_X = 0, I_C, I_CTX, I_CCTX, I_ADAW, I_ADAB, I_N1W, I_WIN, I_SCW, I_SCB, I_DTB, I_ALOG, I_SD, I_SNW, I_QNW, I_KNW, I_RPB, I_PW, I_PS, I_WOUT, I_N2W, I_WUP, I_MCW, I_MCB, I_WDN };

template <bool FFN_PERM = false, bool DEEP = false>
__device__ __forceinline__ void p0_transpose_item(const float* W, int K, int N, bf16* WT, LAS float* scr, int item, int lane) {
    const int nblk = N / 32, kb = item / nblk, nb = item % nblk, k0 = 64 * kb, n0 = 32 * nb;
    const int n0o = FFN_PERM ? (n0 < DFF ? 256 * (n0 / 128) + (n0 % 128) : 256 * ((n0 - DFF) / 128) + 128 + ((n0 - DFF) % 128)) : n0;
    if (DEEP) {
        float v[32];
#pragma unroll
        for (int i = 0; i < 32; ++i) { const int kk = 2 * i + (lane >> 5); v[i] = W[(size_t)(k0 + kk) * N + n0 + (lane & 31)]; }
#pragma unroll
        for (int i = 0; i < 32; ++i) { const int kk = 2 * i + (lane >> 5); scr[kk * 33 + (lane & 31)] = v[i]; }
    } else {
#pragma unroll 8
    for (int i = 0; i < 32; ++i) { const int kk = 2 * i + (lane >> 5); scr[kk * 33 + (lane & 31)] = W[(size_t)(k0 + kk) * N + n0 + (lane & 31)]; }
    }
    LDS_WAIT(); asm volatile("" ::: "memory");
    const int c = lane & 7;
#pragma unroll
    for (int j = 0; j < 4; ++j) { const int n = (lane >> 3) + 8 * j; const LAS float* s = scr + (8 * c) * 33 + n;
        v4u o; o.x = pk2(s[0 * 33], s[1 * 33]); o.y = pk2(s[2 * 33], s[3 * 33]); o.z = pk2(s[4 * 33], s[5 * 33]); o.w = pk2(s[6 * 33], s[7 * 33]);
        *(GAS v4u*)(WT + (size_t)(n0o + n) * K + k0 + 8 * c) = o; }
    LDS_WAIT(); asm volatile("" ::: "memory");
}

__device__ __forceinline__ void prologue_convert_win(Frame& F, int lane, int wave);
__device__ __forceinline__ void s0_prologue(Frame& F) {
    const int tid = opaque_tid(), lane = tid & 63, wave = __builtin_amdgcn_readfirstlane(tid >> 6); (void)lane; (void)wave;
    LAS float* scr = (LAS float*)(F.lds + RING_OFF + wave * 16384);
    const int gw = blockIdx.x * NWAVES + wave, NGW = F.G * NWAVES;
    prologue_convert_win(F, lane, wave);
    for (int it = gw; it < 8 * 32; it += NGW) p0_transpose_item(F.in_(I_PW) + (size_t)(it >> 5) * 65536, 256, 256, (bf16*)(F.ws_() + WS_WPOOL) + (size_t)(it >> 5) * 65536, scr, it & 31, lane);
    {
        const int gt = blockIdx.x * 512 + tid, NT = F.G * 512;
        constexpr int PADV = (NIN - IN_COLS) * D / 8;
        for (int i = gt; i < 2 * PADV; i += NT) { const int l = i / PADV, j = i % PADV;
            *((GAS v4u*)(F.ws_() + WS_WIN + l * SZ_WIN + (size_t)IN_COLS * D * 2) + j) = (v4u){0u, 0u, 0u, 0u}; }
        for (int i = gt; i < 256 * 32; i += NT) { const int pos = i >> 5, fi = i & 31;
            const double inv = exp2(-(double)(2 * fi) / 64.0 * 13.287712379549449); const double th = (double)pos * inv;
            double s, c; sincos(th, &s, &c);
            ((GAS f32x2*)(F.ws_() + WS_ROPE))[i] = (f32x2){(float)c, (float)s}; }
    }
    __syncthreads();
    {
        LAS float* sl = (LAS float*)(F.lds + RING_OFF);
        const float* cv = F.in_(I_C); const float* ccv = F.in_(I_CCTX);
        for (int it = blockIdx.x; it < 2 * 12 * 32; it += F.G) {
            const int l = it / 384, rem = it % 384, cb = rem / 32, kc = rem % 32;
            __syncthreads();
            if (tid < 256) { const int k = kc * 128 + (tid & 127); const float v = (tid < 128) ? cv[k] : ccv[k]; sl[tid] = silu_f(v); }
            __syncthreads();
            const int col = cb * 2048 + tid * 4;
            const float* wp = F.in_(I_ADAW) + ((size_t)l * D + (size_t)kc * 128) * NMOD + col;
            f32x4 a0 = (f32x4){0.f, 0.f, 0.f, 0.f}, a1 = a0;
#pragma unroll 16
            for (int k = 0; k < 128; ++k) { const f32x4 w = *(const GAS f32x4*)(wp + (size_t)k * NMOD); a0 += sl[k] * w; a1 += sl[128 + k] * w; }
            float* part = (float*)(F.ws_() + WS_PART);
            *(GAS f32x4*)(part + ((size_t)(l * 32 + kc) * 2 + 0) * NMOD + col) = a0;
            *(GAS f32x4*)(part + ((size_t)(l * 32 + kc) * 2 + 1) * NMOD + col) = a1;
        }
    }
}
constexpr int CW_Q = 64;
constexpr int Q_CH = 4;
struct TrItem { const float* src; bf16* dst; int K, N; };
template <int L, int SEL> struct QList {
    static constexpr int I_OUT = (L < 0 || SEL == 1) ? 0 : (D / 64) * (D / 32), I_DN = SEL == 1 ? (DFF / 64) * (D / 32) : 0, I_UP = (L < 0 || SEL == 1) ? 0 : (D / 64) * (DFF2 / 32);
    static constexpr int I_IN = (SEL == 0 && L + 1 < DEPTH) ? (D / 64) * (IN_COLS / 32) : 0, NI = I_OUT + I_DN + I_UP + I_IN;
};
template <int L, int SEL = 0>
__device__ __forceinline__ TrItem spare_item(Frame& F, int it) {
    constexpr int I_OUT = QList<L, SEL>::I_OUT, I_DN = QList<L, SEL>::I_DN, I_UP = QList<L, SEL>::I_UP;
    TrItem t;
    if (it < I_OUT) { const int kb = it / (D / 32), nb = it % (D / 32); t.K = D; t.N = D;
        t.src = F.in_(I_WOUT) + (size_t)L * D * D + (size_t)(64 * kb) * D + 32 * nb; t.dst = (bf16*)(F.ws_() + WS_WOUT + L * SZ_WOUT) + (size_t)(32 * nb) * D + 64 * kb; }
    else if (it < I_OUT + I_DN) { const int r = it - I_OUT, kb = r / (D / 32), nb = r % (D / 32); t.K = DFF; t.N = D;
        t.src = F.in_(I_WDN) + (size_t)L * DFF * D + (size_t)(64 * kb) * D + 32 * nb; t.dst = (bf16*)(F.ws_() + WS_WDN + L * SZ_WDN) + (size_t)(32 * nb) * DFF + 64 * kb; }
    else if (it < I_OUT + I_DN + I_UP) { const int r = it - I_OUT - I_DN, kb = r / (DFF2 / 32), nb = r % (DFF2 / 32), n0 = 32 * nb; t.K = D; t.N = DFF2;
        const int n0o = n0 < DFF ? 256 * (n0 / 128) + (n0 % 128) : 256 * ((n0 - DFF) / 128) + 128 + ((n0 - DFF) % 128);
        t.src = F.in_(I_WUP) + (size_t)L * D * DFF2 + (size_t)(64 * kb) * DFF2 + n0; t.dst = (bf16*)(F.ws_() + WS_WUP + L * SZ_WUP) + (size_t)n0o * D + 64 * kb; }
    else { const int r = it - I_OUT - I_DN - I_UP, kb = r / (IN_COLS / 32), nb = r % (IN_COLS / 32); t.K = D; t.N = IN_COLS;
        t.src = F.in_(I_WIN) + (size_t)(L + 1) * D * IN_COLS + (size_t)(64 * kb) * IN_COLS + 32 * nb; t.dst = (bf16*)(F.ws_() + WS_WIN + (L + 1) * SZ_WIN) + (size_t)(32 * nb) * D + 64 * kb; }
    return t;
}
__device__ __forceinline__ void tr_load4(const TrItem& t, int lane, f32x4 (&v)[8]) {
    const float* p = t.src + (size_t)(8 * (lane >> 3)) * t.N + (lane & 7) * 4;
#pragma unroll
    for (int i = 0; i < 8; ++i) v[i] = __builtin_nontemporal_load((const f32x4*)(p + (size_t)i * t.N));
}
__device__ __forceinline__ void tr_store4(const TrItem& t, int lane, const f32x4 (&v)[8]) {
    bf16* d = t.dst + (size_t)(4 * (lane & 7)) * t.K + 8 * (lane >> 3);
#pragma unroll
    for (int e = 0; e < 4; ++e) { v4u o; o.x = pg8::cvt_pk_bf16(v[0][e], v[1][e]); o.y = pg8::cvt_pk_bf16(v[2][e], v[3][e]); o.z = pg8::cvt_pk_bf16(v[4][e], v[5][e]); o.w = pg8::cvt_pk_bf16(v[6][e], v[7][e]);
        __builtin_nontemporal_store(o, (v4u*)(d + (size_t)e * t.K)); }
}
__device__ __forceinline__ int q_grab(gu32* ctr, int lane) {
    unsigned q = 0; if (lane == 0) q = __hip_atomic_fetch_add((unsigned*)ctr, 1u, __ATOMIC_RELAXED, __HIP_MEMORY_SCOPE_AGENT);
    return __builtin_amdgcn_readfirstlane((int)q) * Q_CH;
}
template <int L, int SEL = 0>
__device__ __forceinline__ void spare_convert(Frame& F) {
    const int tid = opaque_tid(), lane = tid & 63;
    constexpr int NI = QList<L, SEL>::NI;
    static_assert(((D / 64) * (D / 32)) % Q_CH == 0 && ((DFF / 64) * (D / 32)) % Q_CH == 0 && ((D / 64) * (DFF2 / 32)) % Q_CH == 0 && ((D / 64) * (IN_COLS / 32)) % Q_CH == 0, "chunks must not straddle matrices");
    gu32* ctr = F.ctl + CW_Q + 64 * L + 32 * SEL;
    int cur = q_grab(ctr, lane), nxt = q_grab(ctr, lane);
    f32x4 v[Q_CH][8];
    if (cur < NI) {
#pragma unroll
        for (int s = 0; s < Q_CH; ++s) { const TrItem t = spare_item<L, SEL>(F, cur + s); tr_load4(t, lane, v[s]); }
    }
#pragma unroll
    for (int s = 0; s < Q_CH; ++s)
#pragma unroll
        for (int i = 0; i < 8; ++i) asm volatile("" : "+v"(v[s][i]));
#pragma unroll 1
    while (cur < NI) {
        unsigned raw = 0; if (lane == 0) asm volatile("global_atomic_add %0, %1, %2, off sc0" : "=v"(raw) : "v"((unsigned long long)(size_t)ctr), "v"(1u) : "memory");
        const int ln = nxt < NI ? nxt : cur;
#pragma unroll
        for (int s = 0; s < Q_CH; ++s) {
            const TrItem tc = spare_item<L, SEL>(F, cur + s);
            tr_store4(tc, lane, v[s]);
            asm volatile("" ::: "memory");
            { const TrItem tn = spare_item<L, SEL>(F, ln + s); tr_load4(tn, lane, v[s]); }
            asm volatile("" ::: "memory");
        }
        asm volatile("s_waitcnt vmcnt(40)" : "+v"(raw) :: "memory");
        cur = nxt; nxt = __builtin_amdgcn_readfirstlane((int)raw) * Q_CH;
    }
}
__device__ __forceinline__ void prologue_convert_win(Frame& F, int lane, int wave) {
    constexpr int NI = (D / 64) * (IN_COLS / 32);
    static_assert(NI % Q_CH == 0, "whole chunks");
    const int step = F.G * NWAVES * Q_CH;
    int cur = (wave * F.G + (int)blockIdx.x) * Q_CH;
    f32x4 v[Q_CH][8];
    if (cur < NI) {
#pragma unroll
        for (int s = 0; s < Q_CH; ++s) { const TrItem t = spare_item<-1>(F, cur + s); tr_load4(t, lane, v[s]); }
    }
#pragma unroll
    for (int s = 0; s < Q_CH; ++s)
#pragma unroll
        for (int i = 0; i < 8; ++i) asm volatile("" : "+v"(v[s][i]));
#pragma unroll 1
    while (cur < NI) {
        const int nxt = cur + step, ln = nxt < NI ? nxt : cur;
#pragma unroll
        for (int s = 0; s < Q_CH; ++s) {
            const TrItem tc = spare_item<-1>(F, cur + s);
            tr_store4(tc, lane, v[s]);
            asm volatile("" ::: "memory");
            { const TrItem tn = spare_item<-1>(F, ln + s); tr_load4(tn, lane, v[s]); }
            asm volatile("" ::: "memory");
        }
        cur = nxt;
    }
}
__device__ __forceinline__ void s1_ada_finalize(Frame& F) {
    const int tid = opaque_tid(), lane = tid & 63, wave = __builtin_amdgcn_readfirstlane(tid >> 6); (void)lane; (void)wave;
    const int gt = blockIdx.x * 512 + tid, NT = F.G * 512;
    const float* part = (const float*)(F.ws_() + WS_PART); float* mod = (float*)(F.ws_() + WS_MOD);
    for (int o = gt; o < 2 * 2 * NMOD; o += NT) { const int l = o / (2 * NMOD), w = (o / NMOD) & 1, n = o % NMOD;
        float s = F.in_(I_ADAB)[l * NMOD + n];
        for (int kc = 0; kc < 32; ++kc) s += part[((size_t)(l * 32 + kc) * 2 + w) * NMOD + n];
        mod[o] = s; }
    if (blockIdx.x == 0 && tid < 16) { const int l = tid >> 3, h = tid & 7; float mq = 0.f, mk = 0.f, mb = 0.f;
        for (int i = 0; i < 128; ++i) { mq = fmaxf(mq, fabsf(F.in_(I_QNW)[l * 128 + i])); mk = fmaxf(mk, fabsf(F.in_(I_KNW)[l * 128 + i])); }
        for (int i = 0; i < 15 * 31; ++i) mb = fmaxf(mb, fabsf(F.in_(I_RPB)[(size_t)(l * 8 + h) * 465 + i]));
        ((float*)(F.ws_() + WS_NAB))[tid] = 128.f * mq * mk * 0.08838834764831845f * 1.02f + mb; }
}
__device__ __forceinline__ const float* modp(Frame& F, int l, int which, int j) { return (const float*)(F.ws_() + WS_MOD) + (size_t)(l * 2 + which) * NMOD + j * D; }

__device__ __forceinline__ void norm_finish_row(const f32x4 (&v)[16], int r, const LAS float* Asel, const LAS float* Bsel, bf16* H, int lane) {
    float s = 0.f;
#pragma unroll
    for (int j = 0; j < 16; ++j) s += (v[j].x * v[j].x + v[j].y * v[j].y) + (v[j].z * v[j].z + v[j].w * v[j].w);
    const float rstd = rsqrtf(wave_sum(s) * (1.f / D) + RMS_EPS);
    GAS v2u* o8 = (GAS v2u*)(H + (size_t)r * D) + lane;
#pragma unroll
    for (int j = 0; j < 16; ++j) { const int e = j * 256 + lane * 4;
        const f32x4 a = *(const LAS f32x4*)(Asel + e), b = *(const LAS f32x4*)(Bsel + e);
        const f32x4 y = v[j] * rstd * a + b;
        v2u o; o.x = pk2(y.x, y.y); o.y = pk2(y.z, y.w); o8[64 * j] = o;
        if ((j & 3) == 3) asm volatile("" ::: "memory"); }
}
template <bool LBF>
__device__ __forceinline__ void norm_mod_phase(Frame& F, const float* src_c, const void* src_l, const float* nw, int l, int jsh, int jsc, const float* spk = nullptr, const float* spk_gate = nullptr, float* xst = nullptr, int r_begin = 0) {
    const int tid = opaque_tid(), lane = tid & 63, wave = __builtin_amdgcn_readfirstlane(tid >> 6);
    const int gw = blockIdx.x * NWAVES + wave, NGW = F.G * NWAVES;
    bf16* H = (bf16*)(F.ws_() + WS_H);
    LAS float* AB = (LAS float*)(F.lds + RING_OFF);
    __syncthreads();
    for (int e = tid; e < D; e += 512) { const float w = nw[e];
        AB[e] = w * (1.f + modp(F, l, 0, jsc)[e]); AB[D + e] = modp(F, l, 0, jsh)[e];
        AB[2 * D + e] = w * (1.f + modp(F, l, 1, jsc)[e]); AB[3 * D + e] = modp(F, l, 1, jsh)[e]; }
    __syncthreads();
    if (spk) for (int r = gw; r < CTX; r += NGW) {
        const GAS f32x4* xr = (const GAS f32x4*)(src_c + (size_t)r * D) + lane;
        f32x4 v[16];
#pragma unroll
        for (int j = 0; j < 16; ++j) { f32x4 a = (f32x4){0.f, 0.f, 0.f, 0.f};
#pragma unroll 1
            for (int k4 = 0; k4 < 16; k4 += 4) { f32x4 t[4];
#pragma unroll
                for (int k = 0; k < 4; ++k) t[k] = *((const GAS f32x4*)(spk + ((size_t)(k4 + k) * CTX + r) * D) + lane + 64 * j);
                a += (t[0] + t[1]) + (t[2] + t[3]); }
            const f32x4 gt = *((const GAS f32x4*)spk_gate + lane + 64 * j);
            const f32x4 x = xr[64 * j] + gt * a; *((GAS f32x4*)(xst + (size_t)r * D) + lane + 64 * j) = x; v[j] = x; }
        norm_finish_row(v, r, AB + 2 * D, AB + 3 * D, H, lane);
    }
    const int rb = spk ? (r_begin > CTX ? r_begin : CTX) : r_begin;
#define NORM_LOAD(V, r) do { if (LBF && (r) >= CTX) { const GAS v2u* xh_ = (const GAS v2u*)((const bf16*)src_l + (size_t)((r) - CTX) * D) + lane; \
            _Pragma("unroll") for (int j = 0; j < 16; ++j) { const v2u w_ = xh_[64 * j]; V[j] = (f32x4){bflo(w_.x), bfhi(w_.x), bflo(w_.y), bfhi(w_.y)}; } } \
        else { const GAS f32x4* xr_ = (const GAS f32x4*)(((r) < CTX) ? src_c + (size_t)(r) * D : (const float*)src_l + (size_t)((r) - CTX) * D) + lane; \
            _Pragma("unroll") for (int j = 0; j < 16; ++j) V[j] = xr_[64 * j]; } } while (0)
#define NORM_FIN(V, r) norm_finish_row(V, r, (r) < CTX ? AB + 2 * D : AB, (r) < CTX ? AB + 3 * D : AB + D, H, lane)
    f32x4 va[16], vb[16];
    int r = rb + gw;
    if (r < R) NORM_LOAD(va, r);
#pragma unroll 1
    while (r < R) {
        const int r1 = r + NGW, r2 = r1 + NGW;
        if (r1 < R) NORM_LOAD(vb, r1);
        NORM_FIN(va, r);
        if (r1 >= R) break;
        if (r2 < R) NORM_LOAD(va, r2);
        NORM_FIN(vb, r1);
        r = r2;
    }
#undef NORM_LOAD
#undef NORM_FIN
    __syncthreads();
}

__device__ __forceinline__ void unpack8(const v4u x, float (&f)[8]) { f[0] = bflo(x.x); f[1] = bfhi(x.x); f[2] = bflo(x.y); f[3] = bfhi(x.y); f[4] = bflo(x.z); f[5] = bfhi(x.z); f[6] = bflo(x.w); f[7] = bfhi(x.w); }
__device__ __forceinline__ void prep_conv(Frame& F, int l, int tid) {
    const bf16* P = (const bf16*)(F.ws_() + WS_P); bf16* XB = (bf16*)(F.ws_() + WS_XBC);
    const float* cw = F.in_(I_SCW) + (size_t)l * 5 * SSD_XBC; const float* cb = F.in_(I_SCB) + (size_t)l * SSD_XBC;
    constexpr int NCHK = SSD_XBC / 8;
    for (int it = blockIdx.x * 512 + tid; it < (R / 64) * NCHK; it += F.G * 512) {
        const int sg = it / NCHK, ch = (it % NCHK) * 8, r0 = sg * 64;
        const int seg_lo = r0 < CTX ? 0 : CTX, seg_hi = r0 < CTX ? CTX : R;
        float w[5][8], bb[8];
#pragma unroll
        for (int k = 0; k < 5; ++k) { const f32x4 a = *(const GAS f32x4*)(cw + k * SSD_XBC + ch), b = *(const GAS f32x4*)(cw + k * SSD_XBC + ch + 4);
            w[k][0] = a.x; w[k][1] = a.y; w[k][2] = a.z; w[k][3] = a.w; w[k][4] = b.x; w[k][5] = b.y; w[k][6] = b.z; w[k][7] = b.w; }
        { const f32x4 a = *(const GAS f32x4*)(cb + ch), b = *(const GAS f32x4*)(cb + ch + 4); bb[0] = a.x; bb[1] = a.y; bb[2] = a.z; bb[3] = a.w; bb[4] = b.x; bb[5] = b.y; bb[6] = b.z; bb[7] = b.w; }
        const bf16* src = P + OFF_XBC + ch;
        const v4u zero = (v4u){0u, 0u, 0u, 0u};
#define PREP_LD(rr) (((rr) >= seg_lo && (rr) < seg_hi) ? *(const GAS v4u*)(src + (size_t)(rr) * NIN) : zero)
        float x0[8], x1[8], x2[8], x3[8], x4[8];
        unpack8(PREP_LD(r0 - 2), x0); unpack8(PREP_LD(r0 - 1), x1); unpack8(PREP_LD(r0), x2); unpack8(PREP_LD(r0 + 1), x3);
        v4u na[5], nb[5];
#define PREP_LD5(buf, rb) do { _Pragma("unroll") for (int k = 0; k < 5; ++k) buf[k] = PREP_LD((rb) + k); } while (0)
#define PREP_STEP(a, b, c, d, e, i, raw) do { const int r = r0 + (i); unpack8(raw, e); \
            if ((i) < 64) { float o[8]; _Pragma("unroll") for (int q = 0; q < 8; ++q) { const float v = bb[q] + w[0][q] * a[q] + w[1][q] * b[q] + w[2][q] * c[q] + w[3][q] * d[q] + w[4][q] * e[q]; o[q] = silu_f(v); } \
                v4u ov; ov.x = pk2(o[0], o[1]); ov.y = pk2(o[2], o[3]); ov.z = pk2(o[4], o[5]); ov.w = pk2(o[6], o[7]); *(GAS v4u*)(XB + (size_t)r * SSD_XBC + ch) = ov; } } while (0)
#define PREP_STEP5(i, buf) do { PREP_STEP(x0, x1, x2, x3, x4, (i), buf[0]); PREP_STEP(x1, x2, x3, x4, x0, (i) + 1, buf[1]); PREP_STEP(x2, x3, x4, x0, x1, (i) + 2, buf[2]); \
            PREP_STEP(x3, x4, x0, x1, x2, (i) + 3, buf[3]); PREP_STEP(x4, x0, x1, x2, x3, (i) + 4, buf[4]); } while (0)
        PREP_LD5(na, r0 + 2);
#pragma unroll 1
        for (int i = 0; i < 60; i += 10) {
            PREP_LD5(nb, r0 + i + 7); PREP_STEP5(i, na);
            PREP_LD5(na, r0 + i + 12); PREP_STEP5(i + 5, nb);
        }
        PREP_STEP5(60, na);
#undef PREP_STEP5
#undef PREP_LD5
#undef PREP_STEP
#undef PREP_LD
    }
}
__device__ __forceinline__ void prep_rows(Frame& F, int l, int lane, int wave) {
    const int gw = blockIdx.x * NWAVES + wave, NGW = F.G * NWAVES;
    const bf16* P = (const bf16*)(F.ws_() + WS_P);
    bf16* QN = (bf16*)(F.ws_() + WS_QN); bf16* KN = (bf16*)(F.ws_() + WS_KN); bf16* PL = (bf16*)(F.ws_() + WS_PL);
    float* DT = (float*)(F.ws_() + WS_DT); float* DA = DT + (size_t)R * 64;
    const GAS f32x2* rope = (const GAS f32x2*)(F.ws_() + WS_ROPE);
    const int hq = lane >> 2, qq = lane & 3, hf = qq >> 1, sb = qq & 1, dA = 64 * hf + 16 * sb;
    const bool isk = hq >= 8;
    float wa[16], wb[16];
    { const float* w = (isk ? F.in_(I_KNW) : F.in_(I_QNW)) + l * 128;
#pragma unroll
      for (int j = 0; j < 16; ++j) { wa[j] = w[dA + j]; wb[j] = w[dA + 32 + j]; } }
    const float dtb = F.in_(I_DTB)[l * 64 + lane], aneg = -__expf(F.in_(I_ALOG)[l * 64 + lane]);
#pragma unroll 1
    for (int r = gw; r < R; r += NGW) {
        const bool isc = r < CTX; const int seg_lo = isc ? 0 : CTX, seg_hi = isc ? CTX : R;
        { const float v = bf2f(P[(size_t)r * NIN + OFF_DT + lane]) + dtb;
          const float dt = fmaxf(v, 0.f) + log1pf(__expf(-fabsf(v)));
          DT[(size_t)r * 64 + lane] = dt; DA[(size_t)r * 64 + lane] = dt * aneg; }
        {
            const bf16* src = P + (size_t)r * NIN + (isk ? OFF_K + (hq - 8) * 128 : OFF_Q + hq * 128) + dA;
            const v4u a0 = *(const GAS v4u*)(src), a1 = *(const GAS v4u*)(src + 8), b0 = *(const GAS v4u*)(src + 32), b1 = *(const GAS v4u*)(src + 40);
            float a[16], b[16];
            { float t[8]; unpack8(a0, t);
#pragma unroll
              for (int j = 0; j < 8; ++j) a[j] = t[j]; unpack8(a1, t);
#pragma unroll
              for (int j = 0; j < 8; ++j) a[8 + j] = t[j]; unpack8(b0, t);
#pragma unroll
              for (int j = 0; j < 8; ++j) b[j] = t[j]; unpack8(b1, t);
#pragma unroll
              for (int j = 0; j < 8; ++j) b[8 + j] = t[j]; }
            float ss = 0.f;
#pragma unroll
            for (int j = 0; j < 16; ++j) ss += a[j] * a[j] + b[j] * b[j];
            ss += __shfl_xor(ss, 1); ss += __shfl_xor(ss, 2);
            const float rstd = rsqrtf(ss * (1.f / 128.f) + RMS_EPS);
            const int t = r - CTX, pos = isc ? 0 : (hf == 0 ? t / GRID_W : t % GRID_W);
            const GAS f32x4* rp = (const GAS f32x4*)(rope + pos * 32 + 16 * sb);
            unsigned oa[8], ob[8];
#pragma unroll
            for (int j2 = 0; j2 < 8; ++j2) {
                const f32x4 cs2 = isc ? (f32x4){1.f, 0.f, 1.f, 0.f} : rp[j2];
                const float u0 = a[2 * j2] * rstd * wa[2 * j2], v0 = b[2 * j2] * rstd * wb[2 * j2], u1 = a[2 * j2 + 1] * rstd * wa[2 * j2 + 1], v1 = b[2 * j2 + 1] * rstd * wb[2 * j2 + 1];
                oa[j2] = pk2(u0 * cs2.x - v0 * cs2.y, u1 * cs2.z - v1 * cs2.w);
                ob[j2] = pk2(v0 * cs2.x + u0 * cs2.y, v1 * cs2.z + u1 * cs2.w); }
            bf16* dst = (isk ? KN : QN) + (size_t)r * 1024 + (hq & 7) * 128 + dA;
            *(GAS v4u*)(dst) = (v4u){oa[0], oa[1], oa[2], oa[3]}; *(GAS v4u*)(dst + 8) = (v4u){oa[4], oa[5], oa[6], oa[7]};
            *(GAS v4u*)(dst + 32) = (v4u){ob[0], ob[1], ob[2], ob[3]}; *(GAS v4u*)(dst + 40) = (v4u){ob[4], ob[5], ob[6], ob[7]};
        }
#pragma unroll 1
        for (int it = 0; it < 2; ++it) {
            const int ch = it * 512 + lane * 8, g = ch >> 8, hw = 1 << g;
            const int lo = max(r - hw, seg_lo), hi = min(r + hw, seg_hi);
            const bf16* src = P + OFF_POOL + ch;
            v4u xv[16];
#pragma unroll
            for (int k = 0; k < 16; ++k) { const int rr = r - hw + k; xv[k] = (k < 2 * hw && rr >= seg_lo && rr < seg_hi) ? *(const GAS v4u*)(src + (size_t)rr * NIN) : (v4u){0u, 0u, 0u, 0u}; }
            float a[8] = {0.f, 0.f, 0.f, 0.f, 0.f, 0.f, 0.f, 0.f};
#pragma unroll
            for (int k = 0; k < 16; ++k) { a[0] += bflo(xv[k].x); a[1] += bfhi(xv[k].x); a[2] += bflo(xv[k].y); a[3] += bfhi(xv[k].y); a[4] += bflo(xv[k].z); a[5] += bfhi(xv[k].z); a[6] += bflo(xv[k].w); a[7] += bfhi(xv[k].w); }
            const float ic = 1.f / (float)(hi - lo);
            const v4u x = *(const GAS v4u*)(src + (size_t)r * NIN);
            v4u o; o.x = pk2(a[0] * ic - bflo(x.x), a[1] * ic - bfhi(x.x)); o.y = pk2(a[2] * ic - bflo(x.y), a[3] * ic - bfhi(x.y));
            o.z = pk2(a[4] * ic - bflo(x.z), a[5] * ic - bfhi(x.z)); o.w = pk2(a[6] * ic - bflo(x.w), a[7] * ic - bfhi(x.w));
            *(GAS v4u*)(PL + (size_t)r * 1024 + ch) = o;
        }
    }
}
__device__ __forceinline__ void prep_phase(Frame& F, int l) {
    const int tid = opaque_tid(), lane = tid & 63, wave = __builtin_amdgcn_readfirstlane(tid >> 6);
    prep_conv(F, l, tid);
    prep_rows(F, l, lane, wave);
}

typedef short bf16x8v __attribute__((ext_vector_type(8)));
typedef short bf16x4v __attribute__((ext_vector_type(4)));
constexpr int TS = 272, XS = 144;
constexpr int L_TB = 0, L_TC = 34816, L_XF = 69632, L_XB = 88064, L_HF = 106496, L_HB = 123904, L_CS = 141312;
static_assert(L_CS + 6 * 512 <= RING_BYTES, "SSD LDS map");
__device__ __forceinline__ bf16x4v ds_tr16(unsigned addr) { bf16x4v r; asm volatile("ds_read_b64_tr_b16 %0, %1" : "=v"(r) : "v"(addr) : "memory"); return r; }
__device__ __forceinline__ bf16x8v cat8(bf16x4v a, bf16x4v b) { return __builtin_shufflevector(a, b, 0, 1, 2, 3, 4, 5, 6, 7); }
#define TR_WAIT4(a, b, c, d) asm volatile("s_waitcnt lgkmcnt(0)" : "+v"(a), "+v"(b), "+v"(c), "+v"(d) :: "memory")
__device__ __forceinline__ int chunk_order(int d, int s) { return d == 0 ? s : (s < 2 ? 1 - s : (NCHUNK - 1) - (s - 2)); }

__device__ __forceinline__ int vwg(int G) { const int b = (int)blockIdx.x; return (G % 8 == 0) ? (b & 7) * (G >> 3) + (b >> 3) : b; }
struct SsdPre { v4u b[4], c[4], hh[4], x[2]; float a0, a1, t0, t1; };
__device__ __forceinline__ v4u ldg16(const void* ubase, unsigned voff) { return *(const GAS v4u*)((const GAS unsigned char*)ubase + voff); }
template <bool OUT>
__device__ __forceinline__ void ssd_fetch(Frame& F, SsdPre& p, int c, int h, int tid, int lane, int wave) {
    const int r0 = c * 128, g = h >> 3;
    const bf16* XBr = (const bf16*)(F.ws_() + WS_XBC) + (size_t)r0 * SSD_XBC;
    const unsigned offT = (unsigned)(((tid >> 4) * SSD_XBC + (tid & 15) * 8) * 2);
    const unsigned offX = (unsigned)(((tid >> 3) * SSD_XBC + (tid & 7) * 8) * 2);
#pragma unroll
    for (int i = 0; i < 4; ++i) {
        p.b[i] = ldg16(XBr + (size_t)(32 * i) * SSD_XBC + SSD_DI + g * 128, offT);
        if (OUT) p.c[i] = ldg16(XBr + (size_t)(32 * i) * SSD_XBC + SSD_DI + SSD_GN + g * 128, offT); }
#pragma unroll
    for (int i = 0; i < 2; ++i) p.x[i] = ldg16(XBr + (size_t)(64 * i) * SSD_XBC + h * 64, offX);
    if (wave < 2) { const int dcol = wave * 32 + h; const float* DT = (const float*)(F.ws_() + WS_DT); const float* DA = DT + (size_t)R * 64;
        int ln = lane; asm volatile("" : "+v"(ln));
        p.a0 = DA[(size_t)(r0 + 2 * ln) * 64 + dcol]; p.a1 = DA[(size_t)(r0 + 2 * ln + 1) * 64 + dcol];
        p.t0 = DT[(size_t)(r0 + 2 * ln) * 64 + dcol]; p.t1 = DT[(size_t)(r0 + 2 * ln + 1) * 64 + dcol]; }
}
__device__ __forceinline__ void ssd_fetch_h(Frame& F, SsdPre& p, int c, int h, int tid) {
    const bf16* HIN = (const bf16*)(F.ws_() + WS_HIN);
    const unsigned offH = (unsigned)(((tid >> 4) * 128 + (tid & 15) * 8) * 2);
#pragma unroll
    for (int i = 0; i < 4; ++i) p.hh[i] = ldg16(HIN + ((size_t)(c * 64 + (i >> 1) * 32 + h) * 64 + 32 * (i & 1)) * 128, offH);
}
__device__ __forceinline__ void ssd_commit_h(Frame& F, const SsdPre& p, int tid) {
#pragma unroll
    for (int i = 0; i < 4; ++i) { const int q = tid + 512 * i, d = q >> 10, qq = q & 1023, row = qq >> 4, ch = qq & 15;
        *(LAS v4u*)(F.lds + (d ? L_HB : L_HF) + row * TS + ch * 16) = p.hh[i]; }
}
template <bool STATES>
__device__ __forceinline__ void ssd_stage_cs(Frame& F, const SsdPre& p, int c, int h, int lane, int wave) {
    if (wave < 2) {
        const int d = wave, dcol = d * 32 + h;
        LAS float* cs = (LAS float*)(F.lds + L_CS);
        const float a0 = p.a0, a1 = p.a1, t0 = p.t0, t1 = p.t1;
        float sc = a0 + a1;
#pragma unroll
        for (int o = 1; o < 64; o <<= 1) { const float v = __shfl_up(sc, o); if (lane >= o) sc += v; }
        const float tot = __shfl(sc, 63);
        const float c1 = sc, c0 = sc - a1;
        float k0, k1, e0, e1;
        if (d == 0) { k0 = c0; k1 = c1; e0 = STATES ? t0 * __expf(tot - c0) : __expf(c0); e1 = STATES ? t1 * __expf(tot - c1) : __expf(c1); }
        else { k0 = tot - c0 + a0; k1 = tot - c1 + a1; e0 = STATES ? t0 * __expf(tot - k0) : __expf(k0); e1 = STATES ? t1 * __expf(tot - k1) : __expf(k1); }
        cs[d * 128 + 2 * lane] = k0; cs[d * 128 + 2 * lane + 1] = k1;
        cs[(2 + d) * 128 + 2 * lane] = e0; cs[(2 + d) * 128 + 2 * lane + 1] = e1;
        cs[(4 + d) * 128 + 2 * lane] = t0; cs[(4 + d) * 128 + 2 * lane + 1] = t1;
        if (STATES && lane == 0) ((float*)(F.ws_() + WS_CHD))[c * 64 + dcol] = __expf(tot);
    }
}
template <bool OUT>
__device__ __forceinline__ void ssd_commit_tiles(Frame& F, const SsdPre& p, int tid) {
#pragma unroll
    for (int i = 0; i < 4; ++i) { const int q = tid + 512 * i, row = q >> 4, ch = q & 15;
        *(LAS v4u*)(F.lds + L_TB + row * TS + ch * 16) = p.b[i];
        if (OUT) *(LAS v4u*)(F.lds + L_TC + row * TS + ch * 16) = p.c[i]; }
}
__device__ __forceinline__ void ssd_commit_x(Frame& F, const SsdPre& p, const LAS float* sf, const LAS float* sb, int tid) {
#pragma unroll
    for (int i = 0; i < 2; ++i) { const int q = tid + 512 * i, row = q >> 3, ch = q & 7;
        const v4u x = p.x[i];
        const float wf = sf[row], wb = sb[row];
        const float xf[8] = {bflo(x.x), bfhi(x.x), bflo(x.y), bfhi(x.y), bflo(x.z), bfhi(x.z), bflo(x.w), bfhi(x.w)};
        v4u of, ob;
        of.x = pk2(xf[0] * wf, xf[1] * wf); of.y = pk2(xf[2] * wf, xf[3] * wf); of.z = pk2(xf[4] * wf, xf[5] * wf); of.w = pk2(xf[6] * wf, xf[7] * wf);
        ob.x = pk2(xf[0] * wb, xf[1] * wb); ob.y = pk2(xf[2] * wb, xf[3] * wb); ob.z = pk2(xf[4] * wb, xf[5] * wb); ob.w = pk2(xf[6] * wb, xf[7] * wb);
        *(LAS v4u*)(F.lds + L_XF + row * XS + ch * 16) = of; *(LAS v4u*)(F.lds + L_XB + row * XS + ch * 16) = ob; }
}

__device__ __forceinline__ void ssd_states_compute(Frame& F, int c, int h, int tid, int lane, int wave) {
    const int pt = wave & 3, nh = wave >> 2, p0 = 16 * pt, lg = lane >> 4, q4 = (lane & 15) >> 2, pp = lane & 3;
    const unsigned ldsb = (unsigned)(size_t)F.lds;
    f32x4 accf[4], accb[4];
#pragma unroll
    for (int i = 0; i < 4; ++i) { accf[i] = (f32x4){0.f, 0.f, 0.f, 0.f}; accb[i] = (f32x4){0.f, 0.f, 0.f, 0.f}; }
#pragma unroll
    for (int ks = 0; ks < 4; ++ks) {
        const int jrow = 32 * ks + 8 * lg + q4;
        const unsigned ax = ldsb + (unsigned)(jrow * XS + (p0 + 4 * pp) * 2);
        bf16x4v afl = ds_tr16(ax + L_XF), afh = ds_tr16(ax + L_XF + 4 * XS), abl = ds_tr16(ax + L_XB), abh = ds_tr16(ax + L_XB + 4 * XS);
        bf16x4v bl[4], bh[4];
#pragma unroll
        for (int nt = 0; nt < 4; ++nt) { const unsigned ab = ldsb + (unsigned)(L_TB + jrow * TS + (nh * 64 + 16 * nt + 4 * pp) * 2); bl[nt] = ds_tr16(ab); bh[nt] = ds_tr16(ab + 4 * TS); }
        TR_WAIT4(afl, afh, abl, abh); TR_WAIT4(bl[0], bh[0], bl[1], bh[1]); TR_WAIT4(bl[2], bh[2], bl[3], bh[3]);
        const bf16x8v af = cat8(afl, afh), ab8 = cat8(abl, abh);
#pragma unroll
        for (int nt = 0; nt < 4; ++nt) { const bf16x8v b8 = cat8(bl[nt], bh[nt]);
            accf[nt] = __builtin_amdgcn_mfma_f32_16x16x32_bf16(af, b8, accf[nt], 0, 0, 0);
            accb[nt] = __builtin_amdgcn_mfma_f32_16x16x32_bf16(ab8, b8, accb[nt], 0, 0, 0); }
    }
    LAS unsigned char* ot = F.lds + L_TC;
#pragma unroll
    for (int nt = 0; nt < 4; ++nt)
#pragma unroll
        for (int rg = 0; rg < 4; ++rg) { const int p = p0 + 4 * lg + rg, n = nh * 64 + 16 * nt + (lane & 15);
            *(LAS bf16*)(ot + p * TS + n * 2) = (bf16)f2bf(accf[nt][rg]);
            *(LAS bf16*)(ot + (64 + p) * TS + n * 2) = (bf16)f2bf(accb[nt][rg]); }
    __syncthreads();
    bf16* SE = (bf16*)(F.ws_() + WS_SEND);
#pragma unroll
    for (int i = 0; i < 4; ++i) { const int q = tid + 512 * i, d = q >> 10, p = (q & 1023) >> 4, ch = q & 15;
        *(GAS v4u*)(SE + ((size_t)(c * 64 + d * 32 + h) * 64 + p) * 128 + ch * 8) = *(const LAS v4u*)(ot + (d * 64 + p) * TS + ch * 16); }
}

__device__ __forceinline__ void ssd_chunk_scan_phase(Frame& F) {
    const int tid = opaque_tid();
    const bf16* SE = (const bf16*)(F.ws_() + WS_SEND); const float* CHD = (const float*)(F.ws_() + WS_CHD); bf16* HIN = (bf16*)(F.ws_() + WS_HIN);
    for (int e = blockIdx.x * 512 + tid; e < 64 * 64 * 32; e += F.G * 512) {
        const int dh = e >> 11, rem = e & 2047, d = dh >> 5;
        f32x4 hst = (f32x4){0.f, 0.f, 0.f, 0.f};
#pragma unroll 1
        for (int s0 = 0; s0 < NCHUNK; s0 += 10) {
            f32x4 sv[10]; float dec[10]; int cc[10];
#pragma unroll
            for (int k = 0; k < 10; ++k) { cc[k] = chunk_order(d, s0 + k); { const v2u w = *(const GAS v2u*)(SE + ((size_t)(cc[k] * 64 + dh) * 2048 + rem) * 4); sv[k] = (f32x4){bflo(w.x), bfhi(w.x), bflo(w.y), bfhi(w.y)}; } dec[k] = CHD[cc[k] * 64 + dh]; }
#pragma unroll
            for (int k = 0; k < 10; ++k) { v2u o; o.x = pk2(hst.x, hst.y); o.y = pk2(hst.z, hst.w);
                *(GAS v2u*)(HIN + ((size_t)(cc[k] * 64 + dh) * 2048 + rem) * 4) = o;
                hst = dec[k] * hst + sv[k]; }
        }
    }
}

__device__ __forceinline__ void ssd_out_compute(Frame& F, int l, int c, int h, int tid, int lane, int wave) {
    const int r0 = c * 128;
    LAS float* cs = (LAS float*)(F.lds + L_CS);
    const int i0 = 16 * wave, lg = lane >> 4, lc = lane & 15, q4 = lc >> 2, pp = lane & 3;
    const unsigned ldsb = (unsigned)(size_t)F.lds;
    bf16x8v cfr[4];
#pragma unroll
    for (int ks = 0; ks < 4; ++ks) cfr[ks] = *(const LAS bf16x8v*)(F.lds + L_TC + (i0 + lc) * TS + (32 * ks + 8 * lg) * 2);
    f32x4 cb[8];
#pragma unroll
    for (int jt = 0; jt < 8; ++jt) { cb[jt] = (f32x4){0.f, 0.f, 0.f, 0.f};
#pragma unroll
        for (int ks = 0; ks < 4; ++ks) { const bf16x8v bfr = *(const LAS bf16x8v*)(F.lds + L_TB + (16 * jt + lc) * TS + (32 * ks + 8 * lg) * 2);
            cb[jt] = __builtin_amdgcn_mfma_f32_16x16x32_bf16(cfr[ks], bfr, cb[jt], 0, 0, 0); }
        if (jt & 1) asm volatile("" ::: "memory"); }
    f32x4 yof[4], yob[4], yd[4];
#pragma unroll
    for (int pt = 0; pt < 4; ++pt) { yof[pt] = (f32x4){0.f, 0.f, 0.f, 0.f}; yob[pt] = (f32x4){0.f, 0.f, 0.f, 0.f}; yd[pt] = (f32x4){0.f, 0.f, 0.f, 0.f};
#pragma unroll
        for (int ks = 0; ks < 4; ++ks) {
            const bf16x8v hf = *(const LAS bf16x8v*)(F.lds + L_HF + (16 * pt + lc) * TS + (32 * ks + 8 * lg) * 2);
            const bf16x8v hb = *(const LAS bf16x8v*)(F.lds + L_HB + (16 * pt + lc) * TS + (32 * ks + 8 * lg) * 2);
            yof[pt] = __builtin_amdgcn_mfma_f32_16x16x32_bf16(cfr[ks], hf, yof[pt], 0, 0, 0);
            yob[pt] = __builtin_amdgcn_mfma_f32_16x16x32_bf16(cfr[ks], hb, yob[pt], 0, 0, 0); }
        asm volatile("" ::: "memory"); }
    __syncthreads();
    float csi_f[4], csi_b[4];
#pragma unroll
    for (int rg = 0; rg < 4; ++rg) { csi_f[rg] = cs[i0 + 4 * lg + rg]; csi_b[rg] = cs[128 + i0 + 4 * lg + rg]; }
#pragma unroll
    for (int d = 0; d < 2; ++d) {
        const int kslo = d == 0 ? 0 : (wave >> 1), kshi = d == 0 ? (wave >> 1) : 3;
#pragma unroll
        for (int jt = 0; jt < 8; ++jt) {
            if ((jt >> 1) < kslo || (jt >> 1) > kshi) continue;
            const int j = 16 * jt + lc;
            if (d == 0 ? (jt <= wave) : (jt >= wave)) {
                const float kj = cs[d * 128 + j];
#pragma unroll
                for (int rg = 0; rg < 4; ++rg) { const int i = i0 + 4 * lg + rg; const bool ok = d == 0 ? (j <= i) : (j >= i);
                    const float ki = d == 0 ? csi_f[rg] : csi_b[rg];
                    const float m = ok ? cb[jt][rg] * __expf(ki - kj) : 0.f;
                    *(LAS bf16*)(F.lds + L_TB + i * TS + j * 2) = (bf16)f2bf(m); }
            } else {
#pragma unroll
                for (int rg = 0; rg < 4; ++rg) *(LAS bf16*)(F.lds + L_TB + (i0 + 4 * lg + rg) * TS + j * 2) = (bf16)0;
            }
        }
        LDS_WAIT(); asm volatile("" ::: "memory");
#pragma unroll
        for (int ks = 0; ks < 4; ++ks) {
            if (ks < kslo || ks > kshi) continue;
            const bf16x8v mfr = *(const LAS bf16x8v*)(F.lds + L_TB + (i0 + lc) * TS + (32 * ks + 8 * lg) * 2);
            const unsigned ax = ldsb + (unsigned)((d ? L_XB : L_XF) + (32 * ks + 8 * lg + q4) * XS + 4 * pp * 2);
            bf16x4v xl[4], xh[4];
#pragma unroll
            for (int pt = 0; pt < 4; ++pt) { xl[pt] = ds_tr16(ax + 32 * pt); xh[pt] = ds_tr16(ax + 32 * pt + 4 * XS); }
            TR_WAIT4(xl[0], xh[0], xl[1], xh[1]); TR_WAIT4(xl[2], xh[2], xl[3], xh[3]);
#pragma unroll
            for (int pt = 0; pt < 4; ++pt) yd[pt] = __builtin_amdgcn_mfma_f32_16x16x32_bf16(mfr, cat8(xl[pt], xh[pt]), yd[pt], 0, 0, 0);
        }
        LDS_WAIT(); asm volatile("" ::: "memory");
    }
    const float dsk = F.in_(I_SD)[l * 32 + h];
    LAS unsigned char* yt = F.lds + L_TC;
#pragma unroll
    for (int rg = 0; rg < 4; ++rg) { const int i = i0 + 4 * lg + rg; const float ef = cs[2 * 128 + i], eb = cs[3 * 128 + i], rdt = __builtin_amdgcn_rcpf(cs[4 * 128 + i]);
#pragma unroll
        for (int pt = 0; pt < 4; ++pt) { const int p = 16 * pt + lc;
            const float xr = bf2f(*(const LAS bf16*)(F.lds + L_XF + i * XS + p * 2)) * rdt;
            *(LAS bf16*)(yt + i * XS + p * 2) = (bf16)f2bf(yd[pt][rg] + ef * yof[pt][rg] + eb * yob[pt][rg] + dsk * xr); } }
    __syncthreads();
    bf16* Y = (bf16*)(F.ws_() + WS_Y);
#pragma unroll
    for (int i2 = 0; i2 < 2; ++i2) { const int q = tid + 512 * i2, row = q >> 3, ch = q & 7;
        *(GAS v4u*)(Y + (size_t)(r0 + row) * SSD_DI + h * 64 + ch * 8) = *(const LAS v4u*)(yt + row * XS + ch * 16); }
}

__device__ __forceinline__ void ssd_states_loop(Frame& F, int tid, int lane, int wave) {
    LAS float* cs = (LAS float*)(F.lds + L_CS);
    SsdPre p; int u = vwg(F.G);
    if (u < NCHUNK * 32) ssd_fetch<false>(F, p, u >> 5, u & 31, tid, lane, wave);
#pragma unroll 1
    for (; u < NCHUNK * 32; u += F.G) {
        const int c = u >> 5, h = u & 31;
        __syncthreads();
        ssd_stage_cs<true>(F, p, c, h, lane, wave);
        ssd_commit_tiles<false>(F, p, tid);
        __syncthreads();
        ssd_commit_x(F, p, cs + 2 * 128, cs + 3 * 128, tid);
        if (u + F.G < NCHUNK * 32) ssd_fetch<false>(F, p, (u + F.G) >> 5, (u + F.G) & 31, tid, lane, wave);
        __syncthreads();
        ssd_states_compute(F, c, h, tid, lane, wave);
    }
}
__device__ __forceinline__ void ssd_out_loop(Frame& F, int l, int tid, int lane, int wave) {
    LAS float* cs = (LAS float*)(F.lds + L_CS);
    SsdPre p; int u = vwg(F.G);
    if (u < NCHUNK * 32) ssd_fetch<true>(F, p, u >> 5, u & 31, tid, lane, wave);
#pragma unroll 1
    for (; u < NCHUNK * 32; u += F.G) {
        const int c = u >> 5, h = u & 31;
        __syncthreads();
        ssd_fetch_h(F, p, c, h, tid);
        ssd_stage_cs<false>(F, p, c, h, lane, wave);
        ssd_commit_tiles<true>(F, p, tid);
        __syncthreads();
        ssd_commit_x(F, p, cs + 4 * 128, cs + 5 * 128, tid);
        ssd_commit_h(F, p, tid);
        if (u + F.G < NCHUNK * 32) ssd_fetch<true>(F, p, (u + F.G) >> 5, (u + F.G) & 31, tid, lane, wave);
        __syncthreads();
        ssd_out_compute(F, l, c, h, tid, lane, wave);
    }
}

constexpr int NA_VS = 272, NA_VTILE = 32 * NA_VS, NA_VBUF = NA_VTILE + 1920;
__device__ __forceinline__ void na_unit(Frame& F, int l, int qb, int h, LAS unsigned char* vbuf, int lane) {
    const int lc = lane & 15, lg = lane >> 4, q4 = lc >> 2, pp = lane & 3;
    const bf16* QN = (const bf16*)(F.ws_() + WS_QN); const bf16* KN = (const bf16*)(F.ws_() + WS_KN); const bf16* P = (const bf16*)(F.ws_() + WS_P);
    bf16* MIX = (bf16*)(F.ws_() + WS_MIX);
    const bool isc = qb < 16; const int rq0 = qb * 16;
    const int t0 = rq0 - CTX, qr = t0 >> 6, b = (t0 & 63) >> 4;
    const int kc0 = b == 0 ? 0 : (b == 1 ? 8 : (b == 2 ? 24 : 32));
    const int band0 = min(max(qr - 4, 0), 256 - 8);
    const int qc = 16 * b + lc, c0q = min(max(qc - 8, 0), GRID_W - 16);
    const float scale = 0.08838834764831845f;
    const float M = ((const float*)(F.ws_() + WS_NAB))[l * 8 + h];
    LAS float* rtab = (LAS float*)(vbuf + NA_VTILE);
    if (!isc) { const float* rpb = F.in_(I_RPB) + (size_t)(l * 8 + h) * 15 * 31;
#pragma unroll
        for (int i = 0; i < 8; ++i) { const int idx = lane + 64 * i; if (idx < 465) rtab[idx] = rpb[idx]; } }
    bf16x8v qf[4];
#pragma unroll
    for (int ks = 0; ks < 4; ++ks) qf[ks] = *(const GAS bf16x8v*)(QN + (size_t)(rq0 + lc) * 1024 + h * 128 + 32 * ks + 8 * lg);
    f32x4 o[8];
#pragma unroll
    for (int dt = 0; dt < 8; ++dt) o[dt] = (f32x4){0.f, 0.f, 0.f, 0.f};
    float lsum = 0.f;
    const unsigned vb = (unsigned)(size_t)vbuf;
    const int nblk = isc ? 8 : 16;
#define NA_KROW0(blk) ((!isc && (blk) < 8) ? CTX + (band0 + (blk)) * GRID_W + kc0 : (isc ? (blk) : (blk) - 8) * 32)
#define NA_LOADK(blk) do { const int kr0_ = NA_KROW0(blk); \
        _Pragma("unroll") for (int t = 0; t < 2; ++t) _Pragma("unroll") for (int ks = 0; ks < 4; ++ks) kf[t][ks] = *(const GAS bf16x8v*)(KN + (size_t)(kr0_ + 16 * t + lc) * 1024 + h * 128 + 32 * ks + 8 * lg); } while (0)
#define NA_LOADV(blk) do { const int kr0_ = NA_KROW0(blk); \
        _Pragma("unroll") for (int i = 0; i < 8; ++i) { const int idx = lane + 64 * i, row = idx >> 4, ch = idx & 15; vr[i] = *(const GAS v4u*)(P + (size_t)(kr0_ + row) * NIN + OFF_V + h * 128 + ch * 8); } } while (0)
    bf16x8v kf[2][4]; v4u vr[8];
    NA_LOADK(0); NA_LOADV(0);
#pragma unroll 1
    for (int blk = 0; blk < nblk; ++blk) {
        const bool local = !isc && blk < 8; const int nb = (blk + 1 < nblk) ? blk + 1 : blk;
        f32x4 st[2];
#pragma unroll
        for (int t = 0; t < 2; ++t) { st[t] = (f32x4){0.f, 0.f, 0.f, 0.f};
#pragma unroll
            for (int ks = 0; ks < 4; ++ks) st[t] = __builtin_amdgcn_mfma_f32_16x16x32_bf16(kf[t][ks], qf[ks], st[t], 0, 0, 0); }
        NA_LOADK(nb);
#pragma unroll
        for (int i = 0; i < 8; ++i) { const int idx = lane + 64 * i, row = idx >> 4, ch = idx & 15; *(LAS v4u*)(vbuf + row * NA_VS + ch * 16) = vr[i]; }
        NA_LOADV(nb);
        float p[2][4];
#pragma unroll
        for (int t = 0; t < 2; ++t)
#pragma unroll
            for (int rg = 0; rg < 4; ++rg) {
                float sv = st[t][rg] * scale;
                if (local) { const int kc = kc0 + 16 * t + 4 * lg + rg; const bool ok = (kc >= c0q) && (kc < c0q + 16);
                    const int bi = min(max(kc - qc + 15, 0), 30);
                    const float bias = rtab[(band0 + blk - qr + 7) * 31 + bi];
                    sv = ok ? sv + bias : -INFINITY; }
                const float e = __expf(sv - M); p[t][rg] = e; lsum += e; }
        bf16x8v pf; { v4u w; w.x = pk2(p[0][0], p[0][1]); w.y = pk2(p[0][2], p[0][3]); w.z = pk2(p[1][0], p[1][1]); w.w = pk2(p[1][2], p[1][3]); pf = __builtin_bit_cast(bf16x8v, w); }
        LDS_WAIT(); asm volatile("" ::: "memory");
#pragma unroll
        for (int dh = 0; dh < 2; ++dh) {
            bf16x4v vl[4], vh[4];
#pragma unroll
            for (int k = 0; k < 4; ++k) { const unsigned a = vb + (unsigned)((4 * lg + q4) * NA_VS + (16 * (4 * dh + k) + 4 * pp) * 2); vl[k] = ds_tr16(a); vh[k] = ds_tr16(a + 16 * NA_VS); }
            TR_WAIT4(vl[0], vh[0], vl[1], vh[1]); TR_WAIT4(vl[2], vh[2], vl[3], vh[3]);
#pragma unroll
            for (int k = 0; k < 4; ++k) o[4 * dh + k] = __builtin_amdgcn_mfma_f32_16x16x32_bf16(cat8(vl[k], vh[k]), pf, o[4 * dh + k], 0, 0, 0);
        }
    }
#undef NA_LOADK
#undef NA_LOADV
#undef NA_KROW0
    lsum += __shfl_xor(lsum, 16); lsum += __shfl_xor(lsum, 32);
    const float inv = 1.f / lsum;
    bf16* orow = MIX + (size_t)(rq0 + lc) * D + 2048 + h * 128 + 4 * lg;
#pragma unroll
    for (int dt = 0; dt < 8; ++dt) { v2u w; w.x = pk2(o[dt][0] * inv, o[dt][1] * inv); w.y = pk2(o[dt][2] * inv, o[dt][3] * inv); *(GAS v2u*)(orow + 16 * dt) = w; }
}
constexpr int NAW_TILE = 64 * NA_VS, NAW_BUF = 2 * NAW_TILE, NAW_RTAB = 2 * NAW_BUF;
__device__ __forceinline__ void na_span(const LAS unsigned char* kt, unsigned vt_addr, int k0, bool local, int kcol0, int brow, int qc, int c0q, const LAS float* rtab, float M,
                                        const bf16x8v (&qf)[4], f32x4 (&o)[8], float& lsum, int lc, int lg, int q4, int pp) {
    const float scale = 0.08838834764831845f;
    f32x4 st[2];
#pragma unroll
    for (int t = 0; t < 2; ++t) { st[t] = (f32x4){0.f, 0.f, 0.f, 0.f};
#pragma unroll
        for (int ks = 0; ks < 4; ++ks) { const bf16x8v kf = *(const LAS bf16x8v*)(kt + (k0 + 16 * t + lc) * NA_VS + (32 * ks + 8 * lg) * 2);
            st[t] = __builtin_amdgcn_mfma_f32_16x16x32_bf16(kf, qf[ks], st[t], 0, 0, 0); } }
    float p[2][4];
#pragma unroll
    for (int t = 0; t < 2; ++t)
#pragma unroll
        for (int rg = 0; rg < 4; ++rg) {
            float sv = st[t][rg] * scale;
            if (local) { const int kc = kcol0 + 16 * t + 4 * lg + rg; const bool ok = (kc >= c0q) && (kc < c0q + 16);
                const int bi = min(max(kc - qc + 15, 0), 30);
                const float bias = rtab[brow * 31 + bi];
                sv = ok ? sv + bias : -INFINITY; }
            const float e = __expf(sv - M); p[t][rg] = e; lsum += e; }
    bf16x8v pf; { v4u w; w.x = pk2(p[0][0], p[0][1]); w.y = pk2(p[0][2], p[0][3]); w.z = pk2(p[1][0], p[1][1]); w.w = pk2(p[1][2], p[1][3]); pf = __builtin_bit_cast(bf16x8v, w); }
#pragma unroll
    for (int dh = 0; dh < 2; ++dh) {
        bf16x4v vl[4], vh[4];
#pragma unroll
        for (int k = 0; k < 4; ++k) { const unsigned a = vt_addr + (unsigned)((k0 + 4 * lg + q4) * NA_VS + (16 * (4 * dh + k) + 4 * pp) * 2); vl[k] = ds_tr16(a); vh[k] = ds_tr16(a + 16 * NA_VS); }
        TR_WAIT4(vl[0], vh[0], vl[1], vh[1]); TR_WAIT4(vl[2], vh[2], vl[3], vh[3]);
#pragma unroll
        for (int k = 0; k < 4; ++k) o[4 * dh + k] = __builtin_amdgcn_mfma_f32_16x16x32_bf16(cat8(vl[k], vh[k]), pf, o[4 * dh + k], 0, 0, 0);
    }
}
__device__ __forceinline__ void na_wg_unit(Frame& F, int l, int rgp, int h, int tid, int lane, int wave) {
    const int lc = lane & 15, lg = lane >> 4, q4 = lc >> 2, pp = lane & 3;
    const bf16* QN = (const bf16*)(F.ws_() + WS_QN); const bf16* KN = (const bf16*)(F.ws_() + WS_KN); const bf16* P = (const bf16*)(F.ws_() + WS_P);
    bf16* MIX = (bf16*)(F.ws_() + WS_MIX);
    const int qr = 4 * rgp + (wave >> 1), bsel = 2 * (wave & 1);
    const int band0 = min(max(qr - 4, 0), 256 - 8);
    const int U0 = min(max(4 * rgp - 4, 0), 256 - 8), U1 = min(max(4 * rgp - 1, 0), 256 - 8) + 7, nrows = U1 - U0 + 1, NI = nrows + 4;
    const float M = ((const float*)(F.ws_() + WS_NAB))[l * 8 + h];
    LAS float* rtab = (LAS float*)(F.lds + RING_OFF + NAW_RTAB);
    __syncthreads();
    { const float* rpb = F.in_(I_RPB) + (size_t)(l * 8 + h) * 15 * 31; if (tid < 465) rtab[tid] = rpb[tid]; }
    bf16x8v qf[2][4]; f32x4 o[2][8]; float lsum[2] = {0.f, 0.f};
#pragma unroll
    for (int qb = 0; qb < 2; ++qb) { const int rq0 = CTX + qr * GRID_W + 16 * (bsel + qb);
#pragma unroll
        for (int ks = 0; ks < 4; ++ks) qf[qb][ks] = *(const GAS bf16x8v*)(QN + (size_t)(rq0 + lc) * 1024 + h * 128 + 32 * ks + 8 * lg);
#pragma unroll
        for (int dt = 0; dt < 8; ++dt) o[qb][dt] = (f32x4){0.f, 0.f, 0.f, 0.f}; }
    v4u kq[2], vq[2];
#define NAW_LOAD(it) do { const int base_ = (it) < nrows ? CTX + (U0 + (it)) * GRID_W : ((it) - nrows) * 64; \
        _Pragma("unroll") for (int i = 0; i < 2; ++i) { const int q = tid + 512 * i, key = q >> 4, ch = q & 15; \
            kq[i] = *(const GAS v4u*)(KN + (size_t)(base_ + key) * 1024 + h * 128 + ch * 8); vq[i] = *(const GAS v4u*)(P + (size_t)(base_ + key) * NIN + OFF_V + h * 128 + ch * 8); } } while (0)
    NAW_LOAD(0);
#pragma unroll 1
    for (int it = 0; it < NI; ++it) {
        LAS unsigned char* buf = F.lds + RING_OFF + (it & 1) * NAW_BUF;
#pragma unroll
        for (int i = 0; i < 2; ++i) { const int q = tid + 512 * i, key = q >> 4, ch = q & 15; *(LAS v4u*)(buf + key * NA_VS + ch * 16) = kq[i]; *(LAS v4u*)(buf + NAW_TILE + key * NA_VS + ch * 16) = vq[i]; }
        if (it + 1 < NI) NAW_LOAD(it + 1);
        __syncthreads();
        const bool local = it < nrows; const int kr = U0 + it;
        if (local && (kr < band0 || kr >= band0 + 8)) continue;
        const unsigned vt_addr = (unsigned)(size_t)(buf + NAW_TILE);
#pragma unroll
        for (int qb = 0; qb < 2; ++qb) { const int b = bsel + qb, qc = 16 * b + lc, c0q = min(max(qc - 8, 0), GRID_W - 16);
            const int kc0 = b == 0 ? 0 : (b == 1 ? 8 : (b == 2 ? 24 : 32));
            if (local) na_span(buf, vt_addr, kc0, true, kc0, kr - qr + 7, qc, c0q, rtab, M, qf[qb], o[qb], lsum[qb], lc, lg, q4, pp);
            else { na_span(buf, vt_addr, 0, false, 0, 0, qc, c0q, rtab, M, qf[qb], o[qb], lsum[qb], lc, lg, q4, pp);
                   na_span(buf, vt_addr, 32, false, 0, 0, qc, c0q, rtab, M, qf[qb], o[qb], lsum[qb], lc, lg, q4, pp); } }
    }
#undef NAW_LOAD
#pragma unroll
    for (int qb = 0; qb < 2; ++qb) { float ls = lsum[qb]; ls += __shfl_xor(ls, 16); ls += __shfl_xor(ls, 32); const float inv = 1.f / ls;
        bf16* orow = MIX + (size_t)(CTX + qr * GRID_W + 16 * (bsel + qb) + lc) * D + 2048 + h * 128 + 4 * lg;
#pragma unroll
        for (int dt = 0; dt < 8; ++dt) { v2u w; w.x = pk2(o[qb][dt][0] * inv, o[qb][dt][1] * inv); w.y = pk2(o[qb][dt][2] * inv, o[qb][dt][3] * inv); *(GAS v2u*)(orow + 16 * dt) = w; } }
}

__device__ __forceinline__ void pool_mm_unit(Frame& F, int l, int u, int lane) {
    const int lc = lane & 15, lg = lane >> 4;
    const int rb = u >> 4, g = (u >> 2) & 3, dq = u & 3, r0 = rb * 16;
    const bf16* PL = (const bf16*)(F.ws_() + WS_PL); bf16* MIX = (bf16*)(F.ws_() + WS_MIX);
    const bf16* WT = (const bf16*)(F.ws_() + WS_WPOOL) + (size_t)(l * 4 + g) * 65536;
    f32x4 acc[4];
#pragma unroll
    for (int nt = 0; nt < 4; ++nt) acc[nt] = (f32x4){0.f, 0.f, 0.f, 0.f};
#pragma unroll
    for (int ks = 0; ks < 8; ++ks) {
        const bf16x8v pf = *(const GAS bf16x8v*)(PL + (size_t)(r0 + lc) * 1024 + g * 256 + 32 * ks + 8 * lg);
#pragma unroll
        for (int nt = 0; nt < 4; ++nt) { const bf16x8v wf = *(const GAS bf16x8v*)(WT + (size_t)(dq * 64 + 16 * nt + lc) * 256 + 32 * ks + 8 * lg);
            acc[nt] = __builtin_amdgcn_mfma_f32_16x16x32_bf16(wf, pf, acc[nt], 0, 0, 0); }
    }
    const float* ps = F.in_(I_PS) + l * 1024 + g * 256 + dq * 64 + 4 * lg;
    bf16* orow = MIX + (size_t)(r0 + lc) * D + 3072 + g * 256 + dq * 64 + 4 * lg;
#pragma unroll
    for (int nt = 0; nt < 4; ++nt) { const f32x4 sc = *(const GAS f32x4*)(ps + 16 * nt);
        v2u w; w.x = pk2(acc[nt][0] * sc.x, acc[nt][1] * sc.y); w.y = pk2(acc[nt][2] * sc.z, acc[nt][3] * sc.w); *(GAS v2u*)(orow + 16 * nt) = w; }
}

constexpr int PW_S = 528;
__device__ __forceinline__ void pool_mm_wg(Frame& F, int l, int rb0, int tid, int lane, int wave) {
    const int lc = lane & 15, lg = lane >> 4;
    const int g = (int)blockIdx.x & 3, jwg = (int)blockIdx.x >> 2, nwg = F.G >> 2;
    const bf16* PL = (const bf16*)(F.ws_() + WS_PL); bf16* MIX = (bf16*)(F.ws_() + WS_MIX);
    const bf16* WT = (const bf16*)(F.ws_() + WS_WPOOL) + (size_t)(l * 4 + g) * 65536;
    __syncthreads();
#pragma unroll 4
    for (int i = 0; i < 16; ++i) { const int q = tid + 512 * i, row = q >> 5, ch = q & 31;
        *(LAS v4u*)(F.lds + RING_OFF + row * PW_S + ch * 16) = *(const GAS v4u*)(WT + (size_t)row * 256 + ch * 8); }
    __syncthreads();
    const float* ps = F.in_(I_PS) + l * 1024 + g * 256 + 4 * lg;
#pragma unroll 1
    for (int rb = rb0 + jwg * NWAVES + wave; rb < R / 16; rb += nwg * NWAVES) {
        const int r0 = rb * 16;
        f32x4 acc[16];
#pragma unroll
        for (int nt = 0; nt < 16; ++nt) acc[nt] = (f32x4){0.f, 0.f, 0.f, 0.f};
        bf16x8v pf[8];
#pragma unroll
        for (int ks = 0; ks < 8; ++ks) pf[ks] = *(const GAS bf16x8v*)(PL + (size_t)(r0 + lc) * 1024 + g * 256 + 32 * ks + 8 * lg);
#pragma unroll
        for (int ks = 0; ks < 8; ++ks) {
#pragma unroll
            for (int nt = 0; nt < 16; ++nt) { const bf16x8v wf = *(const LAS bf16x8v*)(F.lds + RING_OFF + (16 * nt + lc) * PW_S + (32 * ks + 8 * lg) * 2);
                acc[nt] = __builtin_amdgcn_mfma_f32_16x16x32_bf16(wf, pf[ks], acc[nt], 0, 0, 0);
                if ((nt & 7) == 7) asm volatile("" ::: "memory"); } }
        bf16* orow = MIX + (size_t)(r0 + lc) * D + 3072 + g * 256 + 4 * lg;
#pragma unroll
        for (int nt = 0; nt < 16; ++nt) { const f32x4 sc = *(const GAS f32x4*)(ps + 16 * nt);
            v2u w; w.x = pk2(acc[nt][0] * sc.x, acc[nt][1] * sc.y); w.y = pk2(acc[nt][2] * sc.z, acc[nt][3] * sc.w); *(GAS v2u*)(orow + 16 * nt) = w; }
    }
    __syncthreads();
}

__device__ __forceinline__ void ssd_gate_phase(Frame& F, int l) {
    const int tid = opaque_tid(), lane = tid & 63, wave = __builtin_amdgcn_readfirstlane(tid >> 6); (void)lane; (void)wave;
    const int gw = blockIdx.x * NWAVES + wave, NGW = F.G * NWAVES;
    const bf16* P = (const bf16*)(F.ws_() + WS_P);
    const bf16* Y0 = (const bf16*)(F.ws_() + WS_Y);
    bf16* MIX = (bf16*)(F.ws_() + WS_MIX);
    const float* nw = F.in_(I_SNW) + (size_t)l * SSD_DI;
    for (int r = gw; r < R; r += NGW) {
        float v[4][8]; float ss = 0.f;
#pragma unroll
        for (int it = 0; it < 4; ++it) {
            const int ch = it * 512 + lane * 8;
            const v4u zv = *(const GAS v4u*)(P + (size_t)r * NIN + OFF_Z + ch);
            const v4u yv = *(const GAS v4u*)(Y0 + (size_t)r * SSD_DI + ch);
            const float zf[8] = {bflo(zv.x), bfhi(zv.x), bflo(zv.y), bfhi(zv.y), bflo(zv.z), bfhi(zv.z), bflo(zv.w), bfhi(zv.w)};
            const float yf[8] = {bflo(yv.x), bfhi(yv.x), bflo(yv.y), bfhi(yv.y), bflo(yv.z), bfhi(yv.z), bflo(yv.w), bfhi(yv.w)};
#pragma unroll
            for (int e = 0; e < 8; ++e) { const float q = yf[e] * silu_f(zf[e]); v[it][e] = q; ss += q * q; }
        }
        const float rstd = rsqrtf(wave_sum(ss) * (1.f / SSD_DI) + RMS_EPS);
#pragma unroll
        for (int it = 0; it < 4; ++it) { const int ch = it * 512 + lane * 8;
            const f32x4 w0 = *(const GAS f32x4*)(nw + ch), w1 = *(const GAS f32x4*)(nw + ch + 4);
            v4u o; o.x = pk2(v[it][0] * rstd * w0.x, v[it][1] * rstd * w0.y); o.y = pk2(v[it][2] * rstd * w0.z, v[it][3] * rstd * w0.w);
            o.z = pk2(v[it][4] * rstd * w1.x, v[it][5] * rstd * w1.y); o.w = pk2(v[it][6] * rstd * w1.z, v[it][7] * rstd * w1.w);
            *(GAS v4u*)(MIX + (size_t)r * D + ch) = o; }
    }
}

__device__ __forceinline__ void ffn_edge_phase(Frame& F, int l) {
    const int tid = opaque_tid();
    const bf16* E = (const bf16*)(F.ws_() + WS_E); bf16* ACT = (bf16*)(F.ws_() + WS_ACT);
    const float* cw = F.in_(I_MCW) + (size_t)l * 3 * DFF2; const float* cb = F.in_(I_MCB) + (size_t)l * DFF2;
    constexpr int NCH4 = DFF / 4, NBLK = R / 64;
    for (int i = blockIdx.x * 512 + tid; i < NBLK * 2 * NCH4; i += F.G * 512) {
        const int c4 = i % NCH4, bs = i / NCH4, sd = bs & 1, blk = bs >> 1, j = c4 * 4;
        const int col = 256 * (j >> 7) + (j & 127);
        const bf16* ec = E + (size_t)blk * 4 * DFF2 + col;
#define ELD(p) ({ const v2u w_ = *(const GAS v2u*)(p); (f32x4){bflo(w_.x), bfhi(w_.x), bflo(w_.y), bfhi(w_.y)}; })
        const f32x4 z = (f32x4){0.f, 0.f, 0.f, 0.f};
        f32x4 gp, gc, gn, vp, vc, vn;
        if (sd == 0) { const bool has = (blk > 0) && (blk != CTX / 64);
            gp = has ? ELD(ec - DFF2) : z; vp = has ? ELD(ec - DFF2 + 128) : z;
            gc = ELD(ec); vc = ELD(ec + 128); gn = ELD(ec + DFF2); vn = ELD(ec + DFF2 + 128); }
        else { const bool has = (blk < NBLK - 1) && (blk != CTX / 64 - 1);
            gp = ELD(ec + 2 * DFF2); vp = ELD(ec + 2 * DFF2 + 128); gc = ELD(ec + 3 * DFF2); vc = ELD(ec + 3 * DFF2 + 128);
            gn = has ? ELD(ec + 4 * DFF2) : z; vn = has ? ELD(ec + 4 * DFF2 + 128) : z; }
        const f32x4 g0 = *(const GAS f32x4*)(cw + j), g1 = *(const GAS f32x4*)(cw + DFF2 + j), g2 = *(const GAS f32x4*)(cw + 2 * DFF2 + j), gb = *(const GAS f32x4*)(cb + j);
        const f32x4 v0 = *(const GAS f32x4*)(cw + DFF + j), v1 = *(const GAS f32x4*)(cw + DFF2 + DFF + j), v2 = *(const GAS f32x4*)(cw + 2 * DFF2 + DFF + j), vb = *(const GAS f32x4*)(cb + DFF + j);
        const f32x4 G = gb + g0 * gp + g1 * gc + g2 * gn, V = vb + v0 * vp + v1 * vc + v2 * vn;
        v2u o; o.x = pk2(silu_f(G.x) * V.x, silu_f(G.y) * V.y); o.y = pk2(silu_f(G.z) * V.z, silu_f(G.w) * V.w);
        *(GAS v2u*)(ACT + (size_t)(blk * 64 + (sd ? 63 : 0)) * DFF + j) = o;
#undef ELD
    }
}

constexpr int NPH_PRE = 2, NPH_LAYER = 12, NPH = NPH_PRE + DEPTH * NPH_LAYER;
struct Args { const float* in[25]; float* out; unsigned char* ws; int ph_lo, ph_hi; };
__global__ void __launch_bounds__(NWAVES * 64, 2) hymba_fwd(Args args) {
    extern __shared__ __attribute__((aligned(16))) unsigned char lds[];
    Frame F;
    F.lds = (LAS unsigned char*)lds;
    F.MISC = (volatile LAS unsigned*)(F.lds + MISC_OFF);
    { const unsigned slot = (unsigned)__builtin_amdgcn_s_getreg((5 << 11) | 4) & 63u; *(LAS int*)(size_t)((unsigned)TIDTAB_OFF + slot * 256u + (threadIdx.x & 63u) * 4u) = (int)threadIdx.x; }
    const int tid = threadIdx.x;
    F.G = gridDim.x;
    F.ctl = (gu32*)(args.ws + WS_CTL);
    for (int u = tid; u < (LDS_BYTES - LDSCTL_OFF) / 4; u += NWAVES * 64) ((LAS unsigned*)(F.lds + LDSCTL_OFF))[u] = 0u;
    __syncthreads();
#if MK_ONE_LAUNCH
    XcdBarrier bar = xcd_barrier_post((unsigned*)(F.ctl + CW_BAR), F.MISC + 8);
#define GRID_BAR() xcd_barrier(bar)
#else
#define GRID_BAR() do {} while (0)
#endif
    const int lo = args.ph_lo, hi = args.ph_hi;
#define IN(k) (lo <= (k) && (k) < hi)
#define SEAM(k) do { if (IN(k) && IN((k) + 1)) GRID_BAR(); } while (0)

    if (IN(0)) { for (int rep = 0; rep < NREP(100); ++rep) { s0_prologue(F); __syncthreads(); } }
    SEAM(0);
    if (IN(1)) { for (int rep = 0; rep < NREP(101); ++rep) { s1_ada_finalize(F); __syncthreads(); } } SEAM(1);

    { constexpr int l = 0;
        const int pb = NPH_PRE + l * NPH_LAYER;
        const float* xin_c = (l == 0) ? F.in_(I_CTX) : (const float*)(F.ws_() + WS_X2);
        const float* xin_l = (l == 0) ? F.in_(I_X) : (const float*)(F.ws_() + WS_X2) + (size_t)CTX * D;
        float* X1 = (float*)(F.ws_() + WS_X1);
        if (IN(pb + 0)) for (int rep = 0; rep < NREP(0); ++rep) {
            if (l == 0) norm_mod_phase<false>(F, xin_c, xin_l, F.in_(I_N1W) + (size_t)l * D, l, 0, 1);
            else norm_mod_phase<true>(F, (const float*)(F.ws_() + WS_X1), xin_l, F.in_(I_N1W) + (size_t)l * D, l, 0, 1, (const float*)(F.ws_() + WS_SPK), modp(F, l - 1, 1, 5), (float*)(F.ws_() + WS_X2));
        } SEAM(pb + 0);
        if (IN(pb + 1)) {
            constexpr int NT_IN = (R / 256) * (NIN / 256);
            const int rounds = (NT_IN + F.G - 1) / F.G, Gin = (NT_IN + rounds - 1) / rounds;
            if ((int)blockIdx.x < Gin) {
                pg8::Gemm g{(const bf16*)(F.ws_() + WS_H), (const bf16*)(F.ws_() + WS_WIN + l * SZ_WIN), R, NIN, D, D, D}; pg8::StaticOrder S; S.init(R, NIN, Gin, (int)blockIdx.x);
                pg8::EpiBf16 E{(bf16*)(F.ws_() + WS_P), NIN};
                pg8::gemm_phase<pg8::EpiBf16, pg8::StaticOrder, true, true>(F.lds + RING_OFF, g, S, E, opaque_tid());
            }
            __syncthreads();
            spare_convert<l>(F);
        } SEAM(pb + 1);
        if (IN(pb + 2)) { for (int rep = 0; rep < NREP(2); ++rep) { prep_phase(F, l); __syncthreads(); } } SEAM(pb + 2);
        if (IN(pb + 3)) for (int rep = 0; rep < NREP(3); ++rep) {
            const int t3 = opaque_tid(), lane3 = t3 & 63, wave3 = __builtin_amdgcn_readfirstlane(t3 >> 6);
            ssd_states_loop(F, t3, lane3, wave3);
            __syncthreads();
            for (int u = vwg(F.G); u < 64 * 8; u += F.G) na_wg_unit(F, l, u & 63, u >> 6, t3, lane3, wave3);
            __syncthreads();
        } SEAM(pb + 3);
        if (IN(pb + 4)) for (int rep = 0; rep < NREP(4); ++rep) {
            ssd_chunk_scan_phase(F);
            const int t3 = opaque_tid(), lane3 = t3 & 63, wave3 = __builtin_amdgcn_readfirstlane(t3 >> 6);
            LAS unsigned char* vbuf = F.lds + RING_OFF + wave3 * NA_VBUF;
            if (l < DEPTH - 1) for (int u = (int)blockIdx.x * NWAVES + wave3; u < 16 * 8; u += F.G * NWAVES) na_unit(F, l, u & 15, u >> 4, vbuf, lane3);
            const int rb0 = (l < DEPTH - 1) ? 0 : CTX / 16;
            pool_mm_wg(F, l, rb0, t3, lane3, wave3);
            __syncthreads();
        } SEAM(pb + 4);
        if (IN(pb + 5)) for (int rep = 0; rep < NREP(5); ++rep) {
            const int t3 = opaque_tid(), lane3 = t3 & 63, wave3 = __builtin_amdgcn_readfirstlane(t3 >> 6);
            ssd_out_loop(F, l, t3, lane3, wave3);
            __syncthreads();
        } SEAM(pb + 5);
        if (IN(pb + 6)) { for (int rep = 0; rep < NREP(6); ++rep) { ssd_gate_phase(F, l); __syncthreads(); } } SEAM(pb + 6);
        if (IN(pb + 7)) {
            { pg8::Gemm g{(const bf16*)(F.ws_() + WS_MIX), (const bf16*)(F.ws_() + WS_WOUT + l * SZ_WOUT), R, D, D, D, D}; pg8::StaticOrder S; S.init(SEQ, D, F.G, (int)blockIdx.x, 1);
              pg8::EpiResT<(l > 0), true> E{xin_l, X1 + (size_t)CTX * D, modp(F, l, 0, 2), D};
              pg8::gemm_phase<pg8::EpiResT<(l > 0), true>, pg8::StaticOrder, true, true>(F.lds + RING_OFF, g, S, E, opaque_tid()); }
            if (l < DEPTH - 1 && blockIdx.x < 256) { const int pn = (int)blockIdx.x & 15, ks = (int)blockIdx.x >> 4;
              pg8::Gemm g{(const bf16*)(F.ws_() + WS_MIX) + ks * 256, (const bf16*)(F.ws_() + WS_WOUT + l * SZ_WOUT) + ks * 256, CTX, D, 256, D, D}; pg8::OneUnit S{{0, pn}};
              pg8::EpiPart E{(float*)(F.ws_() + WS_SPK) + (size_t)ks * CTX * D, D};
              pg8::gemm_phase<pg8::EpiPart, pg8::OneUnit, true, true>(F.lds + RING_OFF, g, S, E, opaque_tid()); }
        } SEAM(pb + 7);
        if (IN(pb + 8)) for (int rep = 0; rep < NREP(8); ++rep) {
            if (l < DEPTH - 1) norm_mod_phase<true>(F, xin_c, X1 + (size_t)CTX * D, F.in_(I_N2W) + (size_t)l * D, l, 3, 4, (const float*)(F.ws_() + WS_SPK), modp(F, l, 1, 2), X1);
            else norm_mod_phase<true>(F, X1, X1 + (size_t)CTX * D, F.in_(I_N2W) + (size_t)l * D, l, 3, 4, nullptr, nullptr, nullptr, CTX);
        } SEAM(pb + 8);
        if (IN(pb + 9)) {
            pg8::Gemm g{(const bf16*)(F.ws_() + WS_H), (const bf16*)(F.ws_() + WS_WUP + l * SZ_WUP), R, DFF2, D, D, D}; pg8::StaticOrder S; S.init(l == DEPTH - 1 ? SEQ : R, DFF2, F.G, (int)blockIdx.x, l == DEPTH - 1 ? 1 : 0);
            pg8::EpiFFN E{(bf16*)(F.ws_() + WS_ACT), F.in_(I_MCW) + (size_t)l * 3 * DFF2, F.in_(I_MCB) + (size_t)l * DFF2, (pg8::bf16_t*)(F.ws_() + WS_E), DFF};
            pg8::gemm_phase<pg8::EpiFFN, pg8::StaticOrder, true, true>(F.lds + RING_OFF, g, S, E, opaque_tid());
            __syncthreads();
            spare_convert<l, 1>(F);
        } SEAM(pb + 9);
        if (IN(pb + 10)) { for (int rep = 0; rep < NREP(10); ++rep) { ffn_edge_phase(F, l); __syncthreads(); } } SEAM(pb + 10);
        if (IN(pb + 11)) {
            { pg8::Gemm g{(const bf16*)(F.ws_() + WS_ACT), (const bf16*)(F.ws_() + WS_WDN + l * SZ_WDN), R, D, DFF, DFF, DFF}; pg8::StaticOrder S; S.init(SEQ, D, F.G, (int)blockIdx.x, 1);
              float* X2 = (float*)(F.ws_() + WS_X2);
              pg8::EpiResT<true, (l < DEPTH - 1)> E{X1 + (size_t)CTX * D, (l == DEPTH - 1) ? F.out_() : X2 + (size_t)CTX * D, modp(F, l, 0, 5), D};
              pg8::gemm_phase<pg8::EpiResT<true, (l < DEPTH - 1)>, pg8::StaticOrder, true, true>(F.lds + RING_OFF, g, S, E, opaque_tid()); }
            if (l < DEPTH - 1 && blockIdx.x < 256) { const int pn = (int)blockIdx.x & 15, ks = (int)blockIdx.x >> 4;
              const int koff = ks < 6 ? ks * 768 : 4608 + (ks - 6) * 640, kn = ks < 6 ? 768 : 640;
              pg8::Gemm g{(const bf16*)(F.ws_() + WS_ACT) + koff, (const bf16*)(F.ws_() + WS_WDN + l * SZ_WDN) + koff, CTX, D, kn, DFF, DFF}; pg8::OneUnit S{{0, pn}};
              pg8::EpiPart E{(float*)(F.ws_() + WS_SPK) + (size_t)ks * CTX * D, D};
              pg8::gemm_phase<pg8::EpiPart, pg8::OneUnit, true, true>(F.lds + RING_OFF, g, S, E, opaque_tid()); }
        } SEAM(pb + 11);
    }
    { constexpr int l = 1;
        const int pb = NPH_PRE + l * NPH_LAYER;
        const float* xin_c = (l == 0) ? F.in_(I_CTX) : (const float*)(F.ws_() + WS_X2);
        const float* xin_l = (l == 0) ? F.in_(I_X) : (const float*)(F.ws_() + WS_X2) + (size_t)CTX * D;
        float* X1 = (float*)(F.ws_() + WS_X1);
        if (IN(pb + 0)) for (int rep = 0; rep < NREP(0); ++rep) {
            if (l == 0) norm_mod_phase<false>(F, xin_c, xin_l, F.in_(I_N1W) + (size_t)l * D, l, 0, 1);
            else norm_mod_phase<true>(F, (const float*)(F.ws_() + WS_X1), xin_l, F.in_(I_N1W) + (size_t)l * D, l, 0, 1, (const float*)(F.ws_() + WS_SPK), modp(F, l - 1, 1, 5), (float*)(F.ws_() + WS_X2));
        } SEAM(pb + 0);
        if (IN(pb + 1)) {
            constexpr int NT_IN = (R / 256) * (NIN / 256);
            const int rounds = (NT_IN + F.G - 1) / F.G, Gin = (NT_IN + rounds - 1) / rounds;
            if ((int)blockIdx.x < Gin) {
                pg8::Gemm g{(const bf16*)(F.ws_() + WS_H), (const bf16*)(F.ws_() + WS_WIN + l * SZ_WIN), R, NIN, D, D, D}; pg8::StaticOrder S; S.init(R, NIN, Gin, (int)blockIdx.x);
                pg8::EpiBf16 E{(bf16*)(F.ws_() + WS_P), NIN};
                pg8::gemm_phase<pg8::EpiBf16, pg8::StaticOrder, true, true>(F.lds + RING_OFF, g, S, E, opaque_tid());
            }
            __syncthreads();
            spare_convert<l>(F);
        } SEAM(pb + 1);
        if (IN(pb + 2)) { for (int rep = 0; rep < NREP(2); ++rep) { prep_phase(F, l); __syncthreads(); } } SEAM(pb + 2);
        if (IN(pb + 3)) for (int rep = 0; rep < NREP(3); ++rep) {
            const int t3 = opaque_tid(), lane3 = t3 & 63, wave3 = __builtin_amdgcn_readfirstlane(t3 >> 6);
            ssd_states_loop(F, t3, lane3, wave3);
            __syncthreads();
            for (int u = vwg(F.G); u < 64 * 8; u += F.G) na_wg_unit(F, l, u & 63, u >> 6, t3, lane3, wave3);
            __syncthreads();
        } SEAM(pb + 3);
        if (IN(pb + 4)) for (int rep = 0; rep < NREP(4); ++rep) {
            ssd_chunk_scan_phase(F);
            const int t3 = opaque_tid(), lane3 = t3 & 63, wave3 = __builtin_amdgcn_readfirstlane(t3 >> 6);
            LAS unsigned char* vbuf = F.lds + RING_OFF + wave3 * NA_VBUF;
            if (l < DEPTH - 1) for (int u = (int)blockIdx.x * NWAVES + wave3; u < 16 * 8; u += F.G * NWAVES) na_unit(F, l, u & 15, u >> 4, vbuf, lane3);
            const int rb0 = (l < DEPTH - 1) ? 0 : CTX / 16;
            pool_mm_wg(F, l, rb0, t3, lane3, wave3);
            __syncthreads();
        } SEAM(pb + 4);
        if (IN(pb + 5)) for (int rep = 0; rep < NREP(5); ++rep) {
            const int t3 = opaque_tid(), lane3 = t3 & 63, wave3 = __builtin_amdgcn_readfirstlane(t3 >> 6);
            ssd_out_loop(F, l, t3, lane3, wave3);
            __syncthreads();
        } SEAM(pb + 5);
        if (IN(pb + 6)) { for (int rep = 0; rep < NREP(6); ++rep) { ssd_gate_phase(F, l); __syncthreads(); } } SEAM(pb + 6);
        if (IN(pb + 7)) {
            { pg8::Gemm g{(const bf16*)(F.ws_() + WS_MIX), (const bf16*)(F.ws_() + WS_WOUT + l * SZ_WOUT), R, D, D, D, D}; pg8::StaticOrder S; S.init(SEQ, D, F.G, (int)blockIdx.x, 1);
              pg8::EpiResT<(l > 0), true> E{xin_l, X1 + (size_t)CTX * D, modp(F, l, 0, 2), D};
              pg8::gemm_phase<pg8::EpiResT<(l > 0), true>, pg8::StaticOrder, true, true>(F.lds + RING_OFF, g, S, E, opaque_tid()); }
            if (l < DEPTH - 1 && blockIdx.x < 256) { const int pn = (int)blockIdx.x & 15, ks = (int)blockIdx.x >> 4;
              pg8::Gemm g{(const bf16*)(F.ws_() + WS_MIX) + ks * 256, (const bf16*)(F.ws_() + WS_WOUT + l * SZ_WOUT) + ks * 256, CTX, D, 256, D, D}; pg8::OneUnit S{{0, pn}};
              pg8::EpiPart E{(float*)(F.ws_() + WS_SPK) + (size_t)ks * CTX * D, D};
              pg8::gemm_phase<pg8::EpiPart, pg8::OneUnit, true, true>(F.lds + RING_OFF, g, S, E, opaque_tid()); }
        } SEAM(pb + 7);
        if (IN(pb + 8)) for (int rep = 0; rep < NREP(8); ++rep) {
            if (l < DEPTH - 1) norm_mod_phase<true>(F, xin_c, X1 + (size_t)CTX * D, F.in_(I_N2W) + (size_t)l * D, l, 3, 4, (const float*)(F.ws_() + WS_SPK), modp(F, l, 1, 2), X1);
            else norm_mod_phase<true>(F, X1, X1 + (size_t)CTX * D, F.in_(I_N2W) + (size_t)l * D, l, 3, 4, nullptr, nullptr, nullptr, CTX);
        } SEAM(pb + 8);
        if (IN(pb + 9)) {
            pg8::Gemm g{(const bf16*)(F.ws_() + WS_H), (const bf16*)(F.ws_() + WS_WUP + l * SZ_WUP), R, DFF2, D, D, D}; pg8::StaticOrder S; S.init(l == DEPTH - 1 ? SEQ : R, DFF2, F.G, (int)blockIdx.x, l == DEPTH - 1 ? 1 : 0);
            pg8::EpiFFN E{(bf16*)(F.ws_() + WS_ACT), F.in_(I_MCW) + (size_t)l * 3 * DFF2, F.in_(I_MCB) + (size_t)l * DFF2, (pg8::bf16_t*)(F.ws_() + WS_E), DFF};
            pg8::gemm_phase<pg8::EpiFFN, pg8::StaticOrder, true, true>(F.lds + RING_OFF, g, S, E, opaque_tid());
            __syncthreads();
            spare_convert<l, 1>(F);
        } SEAM(pb + 9);
        if (IN(pb + 10)) { for (int rep = 0; rep < NREP(10); ++rep) { ffn_edge_phase(F, l); __syncthreads(); } } SEAM(pb + 10);
        if (IN(pb + 11)) {
            { pg8::Gemm g{(const bf16*)(F.ws_() + WS_ACT), (const bf16*)(F.ws_() + WS_WDN + l * SZ_WDN), R, D, DFF, DFF, DFF}; pg8::StaticOrder S; S.init(SEQ, D, F.G, (int)blockIdx.x, 1);
              float* X2 = (float*)(F.ws_() + WS_X2);
              pg8::EpiResT<true, (l < DEPTH - 1)> E{X1 + (size_t)CTX * D, (l == DEPTH - 1) ? F.out_() : X2 + (size_t)CTX * D, modp(F, l, 0, 5), D};
              pg8::gemm_phase<pg8::EpiResT<true, (l < DEPTH - 1)>, pg8::StaticOrder, true, true>(F.lds + RING_OFF, g, S, E, opaque_tid()); }
            if (l < DEPTH - 1 && blockIdx.x < 256) { const int pn = (int)blockIdx.x & 15, ks = (int)blockIdx.x >> 4;
              const int koff = ks < 6 ? ks * 768 : 4608 + (ks - 6) * 640, kn = ks < 6 ? 768 : 640;
              pg8::Gemm g{(const bf16*)(F.ws_() + WS_ACT) + koff, (const bf16*)(F.ws_() + WS_WDN + l * SZ_WDN) + koff, CTX, D, kn, DFF, DFF}; pg8::OneUnit S{{0, pn}};
              pg8::EpiPart E{(float*)(F.ws_() + WS_SPK) + (size_t)ks * CTX * D, D};
              pg8::gemm_phase<pg8::EpiPart, pg8::OneUnit, true, true>(F.lds + RING_OFF, g, S, E, opaque_tid()); }
        } SEAM(pb + 11);
    }
#undef IN
#undef SEAM
}

extern "C" void kernel_launch(void* const* d_in, const int* in_sizes, int n_in, void* d_out, int out_size, void* d_ws, size_t ws_size, hipStream_t stream) {
    static int grid = 0;
    if (grid == 0) {
        if (n_in != 25 || out_size != SEQ * D || ws_size < WS_END2) { fprintf(stderr, "kernel_launch: unexpected problem shape (n_in %d, out %d, ws %zu, need %zu)\n", n_in, out_size, ws_size, (size_t)WS_END2); grid = -1; return; }
        int dev = 0, cus = 0, per_cu = 0;
        if (hipGetDevice(&dev) != hipSuccess || hipDeviceGetAttribute(&cus, hipDeviceAttributeMultiprocessorCount, dev) != hipSuccess) { grid = -1; return; }
        if (hipFuncSetAttribute((const void*)hymba_fwd, hipFuncAttributeMaxDynamicSharedMemorySize, LDS_BYTES) != hipSuccess) { fprintf(stderr, "kernel_launch: hipFuncSetAttribute failed\n"); grid = -1; return; }
        if (hipOccupancyMaxActiveBlocksPerMultiprocessor(&per_cu, (const void*)hymba_fwd, NWAVES * 64, LDS_BYTES) != hipSuccess || per_cu < 1) { fprintf(stderr, "kernel_launch: occupancy query says %d\n", per_cu); }
        (void)hipGetLastError();
        grid = cus;
    }
    if (grid < 0) return;
    (void)hipMemsetAsync((char*)d_ws + WS_CTL, 0, CTL_ZERO_BYTES, stream);
    Args a{};
    for (int i = 0; i < 25; ++i) a.in[i] = (const float*)d_in[i];
    a.out = (float*)d_out; a.ws = (unsigned char*)d_ws;
#if MK_ONE_LAUNCH
    a.ph_lo = 0; a.ph_hi = NPH;
    hipLaunchKernelGGL(hymba_fwd, dim3(grid), dim3(NWAVES * 64), LDS_BYTES, stream, a);
#else
    for (int k = 0; k < NPH; ++k) { a.ph_lo = k; a.ph_hi = k + 1; hipLaunchKernelGGL(hymba_fwd, dim3(grid), dim3(NWAVES * 64), LDS_BYTES, stream, a); }
#endif
}
```
